# Optimizing an MI355X kernel written in HIP

```python
import jax
import jax.numpy as jnp
from jax import lax
import numpy as np

D_MODEL = 2048
BATCH = 4
SEQ = 4096
DEPTH = 4

HEAD_DIM = 64
ROPE_THETA = 10000.0
NORM_EPS = 1e-6
MOBA_HEADS = 8
MOBA_W = MOBA_HEADS * HEAD_DIM
MOBA_BLOCK = 256
MOBA_TOPK = 3
MOBA_QBLOCK = 32
SSD_HEADS = 8
SSD_HEAD_DIM = 64
SSD_W = SSD_HEADS * SSD_HEAD_DIM
SSD_GROUPS = 2
SSD_STATE = 128
SSD_CONV = 4
SSD_CHUNK = 256
SSD_CONV_CH = SSD_W + 2 * SSD_GROUPS * SSD_STATE
SWA_HEADS = 8
SWA_KV_HEADS = 2
SWA_W = SWA_HEADS * HEAD_DIM
SWA_KV_W = SWA_KV_HEADS * HEAD_DIM
SWA_WINDOW = 128
S5_W = 512
S5_GROUP = 16
S5_GROUPS = S5_W // S5_GROUP
S5_STATE = 64

MIX_W = MOBA_W + SSD_W + SWA_W + S5_W
IN_SPLITS = (MOBA_W, MOBA_W, MOBA_W, MOBA_W,
             SSD_CONV_CH, SSD_HEADS, SSD_W,
             SWA_W, SWA_KV_W, SWA_KV_W, SWA_W,
             S5_W, S5_W)
IN_W = sum(IN_SPLITS)

kernel_name = 'hybrid_parallel_moba_ssd_swa_s5'

F32 = jnp.float32


def rms_norm(x, g):
    xf = x.astype(F32)
    y = xf * lax.rsqrt(jnp.mean(xf * xf, axis=-1, keepdims=True) + NORM_EPS) * g.astype(F32)
    return y.astype(x.dtype)


def rope(x):
    L, D = x.shape[1], x.shape[-1]
    inv = 1.0 / (ROPE_THETA ** (jnp.arange(0, D, 2, dtype=F32) / D))
    ang = jnp.arange(L, dtype=F32)[:, None] * inv[None, :]
    cos = jnp.cos(ang)[None, :, None, :]
    sin = jnp.sin(ang)[None, :, None, :]
    xf = x.astype(F32)
    x1, x2 = xf[..., : D // 2], xf[..., D // 2:]
    return jnp.concatenate([x1 * cos - x2 * sin, x2 * cos + x1 * sin], axis=-1).astype(x.dtype)


def pad_seq(a, mult):
    pad = (-a.shape[1]) % mult
    return jnp.pad(a, [(0, 0), (0, pad)] + [(0, 0)] * (a.ndim - 2))


def moba_attention(q, k, v):
    B, L, H, D = q.shape
    q, k, v = pad_seq(q, MOBA_BLOCK), pad_seq(k, MOBA_BLOCK), pad_seq(v, MOBA_BLOCK)
    Lp = q.shape[1]
    nb = Lp // MOBA_BLOCK
    nq = Lp // MOBA_QBLOCK
    topk = min(MOBA_TOPK, nb)
    scale = D ** -0.5
    kb = k.reshape(B, nb, MOBA_BLOCK, H, D).transpose(0, 3, 1, 2, 4)
    vb = v.reshape(B, nb, MOBA_BLOCK, H, D).transpose(0, 3, 1, 2, 4)
    k_mean = jnp.mean(kb.astype(F32), axis=3)
    qh = q.transpose(0, 2, 1, 3)
    gate = jnp.einsum('bhld,bhnd->bhln', qh.astype(F32), k_mean)
    q_blk = jnp.arange(Lp) // MOBA_BLOCK
    past = jnp.arange(nb)[None, :] < q_blk[:, None]
    gate = jnp.where(past, gate, -jnp.inf)
    _, sel = lax.top_k(gate, topk)
    valid = sel < q_blk[:, None]

    def to_chunks(t):
        t = t.reshape((B, H, nq, MOBA_QBLOCK) + t.shape[3:])
        return jnp.moveaxis(t, 2, 0)

    b_idx = jnp.arange(B)[:, None, None, None]
    h_idx = jnp.arange(H)[None, :, None, None]

    def query_block(args):
        qc, selc, validc, ci = args
        kg = kb[b_idx, h_idx, selc]
        vg = vb[b_idx, h_idx, selc]
        s_sel = jnp.einsum('bhqd,bhqkjd->bhqkj', qc, kg).astype(F32) * scale
        s_sel = jnp.where(validc[..., None], s_sel, -jnp.inf)
        s_sel = s_sel.reshape(B, H, MOBA_QBLOCK, topk * MOBA_BLOCK)
        own = (ci * MOBA_QBLOCK) // MOBA_BLOCK
        ko = lax.dynamic_index_in_dim(kb, own, axis=2, keepdims=False)
        vo = lax.dynamic_index_in_dim(vb, own, axis=2, keepdims=False)
        s_own = jnp.einsum('bhqd,bhjd->bhqj', qc, ko).astype(F32) * scale
        qpos = ci * MOBA_QBLOCK + jnp.arange(MOBA_QBLOCK)
        kpos = own * MOBA_BLOCK + jnp.arange(MOBA_BLOCK)
        s_own = jnp.where(kpos[None, :] <= qpos[:, None], s_own, -jnp.inf)
        p = jax.nn.softmax(jnp.concatenate([s_sel, s_own], axis=-1), axis=-1).astype(qc.dtype)
        p_sel = p[..., : topk * MOBA_BLOCK].reshape(B, H, MOBA_QBLOCK, topk, MOBA_BLOCK)
        p_own = p[..., topk * MOBA_BLOCK:]
        return (jnp.einsum('bhqkj,bhqkjd->bhqd', p_sel, vg)
                + jnp.einsum('bhqj,bhjd->bhqd', p_own, vo))

    out = lax.map(query_block, (to_chunks(qh), to_chunks(sel), to_chunks(valid),
                                jnp.arange(nq, dtype=jnp.int32)))
    out = jnp.moveaxis(out, 0, 2).reshape(B, H, Lp, D).transpose(0, 2, 1, 3)
    return out[:, :L]


def causal_depthwise_conv(x, w, b):
    K, C = w.shape
    y = lax.conv_general_dilated(x, w[:, None, :].astype(x.dtype), window_strides=(1,),
                                 padding=[(K - 1, 0)],
                                 dimension_numbers=('NWC', 'WIO', 'NWC'),
                                 feature_group_count=C)
    return y + b.astype(x.dtype)


def segsum(a):
    T = a.shape[-1]
    cs = jnp.cumsum(a, axis=-1)
    seg = cs[..., :, None] - cs[..., None, :]
    mask = jnp.tril(jnp.ones((T, T), dtype=bool))
    return jnp.where(mask, seg, -jnp.inf)


def ssd_scan(x, dt, A, Bm, Cm):
    b, l, h, p = x.shape
    n = Bm.shape[-1]
    s = SSD_CHUNK
    c = l // s
    X = (x * dt[..., None]).reshape(b, c, s, h, p)
    a = (dt * A).reshape(b, c, s, h).transpose(0, 3, 1, 2)
    Bc = Bm.reshape(b, c, s, h, n)
    Cc = Cm.reshape(b, c, s, h, n)
    a_cum = jnp.cumsum(a, axis=-1)
    cb = jnp.einsum('bclhn,bcshn->bhcls', Cc, Bc)
    y_diag = jnp.einsum('bhcls,bcshp->bclhp', cb * jnp.exp(segsum(a)), X)
    decay_states = jnp.exp(a_cum[..., -1:] - a_cum).transpose(0, 2, 3, 1)
    chunk_states = jnp.einsum('bclhn,bclhp->bchpn', Bc, X * decay_states[..., None])
    chunk_decay = jnp.exp(a_cum[..., -1])

    def pass_state(state, inp):
        st, dec = inp
        return dec[..., None, None] * state + st, state

    _, prev = lax.scan(pass_state, jnp.zeros((b, h, p, n), F32),
                       (jnp.moveaxis(chunk_states, 1, 0), jnp.moveaxis(chunk_decay, 2, 0)))
    prev = jnp.moveaxis(prev, 0, 1)
    y_off = jnp.einsum('bclhn,bchpn->bclhp', Cc, prev) * jnp.exp(a_cum).transpose(0, 2, 3, 1)[..., None]
    return (y_diag + y_off).reshape(b, l, h, p)


def mamba2_mixer(xbc, dt_raw, z, conv_w, conv_b, dt_bias, a_log, d_skip, norm_w):
    B, L, _ = xbc.shape
    xbc = jax.nn.silu(causal_depthwise_conv(xbc, conv_w, conv_b))
    xs, bm, cm = jnp.split(xbc, [SSD_W, SSD_W + SSD_GROUPS * SSD_STATE], axis=-1)
    rep = SSD_HEADS // SSD_GROUPS
    xs = xs.reshape(B, L, SSD_HEADS, SSD_HEAD_DIM).astype(F32)
    bm = jnp.repeat(bm.reshape(B, L, SSD_GROUPS, SSD_STATE).astype(F32), rep, axis=2)
    cm = jnp.repeat(cm.reshape(B, L, SSD_GROUPS, SSD_STATE).astype(F32), rep, axis=2)
    dt = jax.nn.softplus(dt_raw.astype(F32) + dt_bias.astype(F32))
    A = -jnp.exp(a_log.astype(F32))
    y = ssd_scan(pad_seq(xs, SSD_CHUNK), pad_seq(dt, SSD_CHUNK), A,
                 pad_seq(bm, SSD_CHUNK), pad_seq(cm, SSD_CHUNK))[:, :L]
    y = y + d_skip.astype(F32)[:, None] * xs
    y = y.reshape(B, L, SSD_W) * jax.nn.silu(z.astype(F32))
    yg = y.reshape(B, L, SSD_GROUPS, SSD_W // SSD_GROUPS)
    yg = yg * lax.rsqrt(jnp.mean(yg * yg, axis=-1, keepdims=True) + NORM_EPS)
    return (yg.reshape(B, L, SSD_W) * norm_w.astype(F32)).astype(z.dtype)


def swa_attention(q, k, v, sinks):
    B, L, HQ, D = q.shape
    HKV = k.shape[2]
    G = HQ // HKV
    W = SWA_WINDOW
    nb = L // W
    scale = D ** -0.5
    qb = q.reshape(B, nb, W, HKV, G, D)

    def band(t):
        tb = t.reshape(B, nb, W, HKV, D)
        prev = jnp.pad(tb, ((0, 0), (1, 0), (0, 0), (0, 0), (0, 0)))[:, :-1]
        return jnp.concatenate([prev, tb], axis=2)

    kk, vv = band(k), band(v)
    s = jnp.einsum('bnqhgd,bnkhd->bnhgqk', qb, kk).astype(F32) * scale
    qpos = jnp.arange(nb)[:, None, None] * W + jnp.arange(W)[None, :, None]
    kpos = jnp.arange(nb)[:, None, None] * W - W + jnp.arange(2 * W)[None, None, :]
    diff = qpos - kpos
    mask = (diff >= 0) & (diff < W) & (kpos >= 0)
    s = jnp.where(mask[None, :, None, None], s, -jnp.inf)
    sink = jnp.broadcast_to(sinks.astype(F32).reshape(1, 1, HKV, G, 1, 1), s.shape[:-1] + (1,))
    p = jax.nn.softmax(jnp.concatenate([s, sink], axis=-1), axis=-1)[..., :-1].astype(q.dtype)
    return jnp.einsum('bnhgqk,bnkhd->bnqhgd', p, vv).reshape(B, L, HQ, D)


def s5_mixer(u, a_re, a_im, log_dt, b_re, b_im, c_re, c_im, d_skip, glu_w, glu_b):
    B, L, _ = u.shape
    lam = lax.complex(a_re.astype(F32), a_im.astype(F32))
    step = jnp.exp(log_dt.astype(F32))[:, None]
    a_bar = jnp.exp(lam * step)
    b_bar = ((a_bar - 1.0) / lam)[..., None] * lax.complex(b_re.astype(F32), b_im.astype(F32))
    ug = u.astype(F32).reshape(B, L, S5_GROUPS, S5_GROUP)
    bu = jnp.einsum('blgh,gph->blgp', ug.astype(jnp.complex64), b_bar)

    def combine(e1, e2):
        a1, b1 = e1
        a2, b2 = e2
        return a1 * a2, a2 * b1 + b2

    _, states = lax.associative_scan(combine, (jnp.broadcast_to(a_bar, bu.shape), bu), axis=1)
    c = lax.complex(c_re.astype(F32), c_im.astype(F32))
    y = jnp.real(jnp.einsum('blgp,ghp->blgh', states, c)).reshape(B, L, S5_W)
    y = y + d_skip.astype(F32) * u.astype(F32)
    y = jax.nn.gelu(y)
    y = y * jax.nn.sigmoid(y @ glu_w.astype(F32) + glu_b.astype(F32))
    return y.astype(u.dtype)


def hybrid_layer(x, pre_g, post_g, w_in, w_out, conv_w, conv_b, dt_bias, a_log, ssd_d, ssd_norm,
                 sinks, a_re, a_im, log_dt, b_re, b_im, c_re, c_im, s5_d, glu_w, glu_b):
    B, L, _ = x.shape
    h = rms_norm(x, pre_g)
    proj = h @ w_in
    split_points = [int(v) for v in np.cumsum(IN_SPLITS)[:-1]]
    (mq, mk, mv, mg, xbc, dt_raw, z, sq, sk, sv, sg, su, s5g) = jnp.split(proj, split_points, axis=-1)

    def heads(t):
        return t.reshape(B, L, -1, HEAD_DIM)

    y_moba = moba_attention(rope(heads(mq)), rope(heads(mk)), heads(mv)).reshape(B, L, MOBA_W)
    y_moba = y_moba * jax.nn.silu(mg)
    y_ssd = mamba2_mixer(xbc, dt_raw, z, conv_w, conv_b, dt_bias, a_log, ssd_d, ssd_norm)
    y_swa = swa_attention(rope(heads(sq)), rope(heads(sk)), heads(sv), sinks).reshape(B, L, SWA_W)
    y_swa = y_swa * jax.nn.silu(sg)
    y_s5 = s5_mixer(su, a_re, a_im, log_dt, b_re, b_im, c_re, c_im, s5_d, glu_w, glu_b)
    y_s5 = y_s5 * jax.nn.silu(s5g)
    mix = jnp.concatenate([y_moba, y_ssd.astype(x.dtype), y_swa, y_s5], axis=-1)
    return x + rms_norm(mix @ w_out, post_g)


def setup_inputs(seed: int = 0) -> dict:
    key = jax.random.key(seed)
    ks = jax.random.split(key, 24)

    def nrm(k, shape, scale):
        return scale * jax.random.normal(k, shape, F32)

    x = nrm(ks[0], (BATCH, SEQ, D_MODEL), 1.0)
    pre_norm = 1.0 + nrm(ks[1], (DEPTH, D_MODEL), 0.05)
    post_norm = 1.0 + nrm(ks[2], (DEPTH, D_MODEL), 0.05)
    w_in = nrm(ks[3], (DEPTH, D_MODEL, IN_W), D_MODEL ** -0.5)
    w_out = nrm(ks[4], (DEPTH, MIX_W, D_MODEL), MIX_W ** -0.5)
    ssd_conv_w = nrm(ks[5], (DEPTH, SSD_CONV, SSD_CONV_CH), SSD_CONV ** -0.5)
    ssd_conv_b = nrm(ks[6], (DEPTH, SSD_CONV_CH), 0.02)
    dt0 = jnp.exp(jax.random.uniform(ks[7], (DEPTH, SSD_HEADS), F32,
                                     minval=float(np.log(1e-3)), maxval=float(np.log(1e-1))))
    ssd_dt_bias = dt0 + jnp.log(-jnp.expm1(-dt0))
    ssd_a_log = jnp.log(jax.random.uniform(ks[8], (DEPTH, SSD_HEADS), F32, minval=1.0, maxval=16.0))
    ssd_d = 1.0 + nrm(ks[9], (DEPTH, SSD_HEADS), 0.05)
    ssd_norm = 1.0 + nrm(ks[10], (DEPTH, SSD_W), 0.05)
    swa_sinks = nrm(ks[11], (DEPTH, SWA_HEADS), 1.0)
    n_idx = jnp.arange(S5_STATE, dtype=F32)
    s5_a_re = -0.5 + nrm(ks[12], (DEPTH, S5_GROUPS, S5_STATE), 0.01)
    s5_a_im = jnp.pi * n_idx + nrm(ks[13], (DEPTH, S5_GROUPS, S5_STATE), 0.01)
    s5_log_dt = jax.random.uniform(ks[14], (DEPTH, S5_GROUPS), F32,
                                   minval=float(np.log(1e-3)), maxval=float(np.log(1e-1)))
    s5_b_re = nrm(ks[15], (DEPTH, S5_GROUPS, S5_STATE, S5_GROUP), (2 * S5_GROUP) ** -0.5)
    s5_b_im = nrm(ks[16], (DEPTH, S5_GROUPS, S5_STATE, S5_GROUP), (2 * S5_GROUP) ** -0.5)
    s5_c_re = nrm(ks[17], (DEPTH, S5_GROUPS, S5_GROUP, S5_STATE), S5_STATE ** -0.5)
    s5_c_im = nrm(ks[18], (DEPTH, S5_GROUPS, S5_GROUP, S5_STATE), S5_STATE ** -0.5)
    s5_d = nrm(ks[19], (DEPTH, S5_W), 1.0)
    s5_glu_w = nrm(ks[20], (DEPTH, S5_W, S5_W), S5_W ** -0.5)
    s5_glu_b = nrm(ks[21], (DEPTH, S5_W), 0.02)
    return {'x': x, 'pre_norm': pre_norm, 'post_norm': post_norm, 'w_in': w_in, 'w_out': w_out,
            'ssd_conv_w': ssd_conv_w, 'ssd_conv_b': ssd_conv_b, 'ssd_dt_bias': ssd_dt_bias,
            'ssd_a_log': ssd_a_log, 'ssd_d': ssd_d, 'ssd_norm': ssd_norm, 'swa_sinks': swa_sinks,
            's5_a_re': s5_a_re, 's5_a_im': s5_a_im, 's5_log_dt': s5_log_dt,
            's5_b_re': s5_b_re, 's5_b_im': s5_b_im, 's5_c_re': s5_c_re, 's5_c_im': s5_c_im,
            's5_d': s5_d, 's5_glu_w': s5_glu_w, 's5_glu_b': s5_glu_b}


def reference(x, pre_norm, post_norm, w_in, w_out, ssd_conv_w, ssd_conv_b, ssd_dt_bias, ssd_a_log,
              ssd_d, ssd_norm, swa_sinks, s5_a_re, s5_a_im, s5_log_dt, s5_b_re, s5_b_im,
              s5_c_re, s5_c_im, s5_d, s5_glu_w, s5_glu_b):
    for l in range(DEPTH):
        x = hybrid_layer(x, pre_norm[l], post_norm[l], w_in[l], w_out[l],
                         ssd_conv_w[l], ssd_conv_b[l], ssd_dt_bias[l], ssd_a_log[l], ssd_d[l], ssd_norm[l],
                         swa_sinks[l], s5_a_re[l], s5_a_im[l], s5_log_dt[l], s5_b_re[l], s5_b_im[l],
                         s5_c_re[l], s5_c_im[l], s5_d[l], s5_glu_w[l], s5_glu_b[l])
    return x
```

```cpp
#include <hip/hip_runtime.h>
#include <hip/hip_cooperative_groups.h>
#include <cstdio>
#include <cstdint>
namespace cg = cooperative_groups;
__device__ __forceinline__ int opaque_zero() { int z = 0; asm volatile("" : "+v"(z)); return z; }
namespace pg8 {
#define PG8_LAS __attribute__((address_space(3)))
typedef unsigned short bf16_t;
typedef short bf16x8 __attribute__((ext_vector_type(8)));
typedef float f32x4 __attribute__((ext_vector_type(4)));
typedef unsigned u32x4 __attribute__((ext_vector_type(4)));
constexpr int BM = 256, BK = 64, HALF = 128, HTB = HALF * BK * 2  , STAGE_BYTES = 8 * HTB, NXCD = 8, WGM = 8;

__host__ __device__ __forceinline__ int lds_byte(int r, int c) { const int st = (r >> 4) * 2 + (c >> 5), rr = r & 15, cc = c & 31, ob = rr * 64 + cc * 2; return st * 1024 + (ob ^ (((ob >> 9) & 1) << 5)); }
__host__ __device__ __forceinline__ void stage_rc(int b, int& R, int& C) { const int st = b / 1024, sb = b % 1024, swz = sb ^ (((sb >> 9) & 1) << 5); R = (st >> 1) * 16 + swz / 64; C = (st & 1) * 32 + (swz % 64) / 2; }
__host__ __device__ __forceinline__ int perm32(int rho) { const int n = rho >> 4, i = rho & 15; return 8 * (i >> 2) + 4 * n + (i & 3); }

struct Unit { int pm, pn; };
struct Gemm { const bf16_t* A; const bf16_t* Bt; int M, N, K; int lda = 0; };

struct StaticOrder {
    int nM, nN, nwg, G, c;
    __host__ __device__ void init(int M, int N, int G_, int c_) { nM = M / BM; nN = N / BM; nwg = nM * nN; G = G_; c = c_; }
    __host__ __device__ bool next(int i, Unit& u) const {
        const long L = (long)i * G + c; if (L >= nwg) return false;
        int wgid = (int)L; { const int q = nwg / NXCD, r = nwg % NXCD, xcd = wgid % NXCD, off = wgid / NXCD; wgid = (xcd < r ? xcd * (q + 1) : r * (q + 1) + (xcd - r) * q) + off; }
        const int nig = WGM * nN, gid = wgid / nig, fm = gid * WGM, gsz = (nM - fm) < WGM ? (nM - fm) : WGM;
        u.pm = fm + ((wgid % nig) % gsz); u.pn = (wgid % nig) / gsz; return true;
    }
    __device__ __forceinline__ void a_ready(const Unit&) const {}
    __device__ __forceinline__ void done(const Unit&) const {}
};
__device__ __forceinline__ unsigned cvt_pk_bf16(float lo, float hi) { unsigned r; asm volatile("v_cvt_pk_bf16_f32 %0, %1, %2" : "=v"(r) : "v"(lo), "v"(hi)); return r; }

template <class Epi, class Sched, bool ALIGN_EPI = false, bool SP2 = false>
__device__ __forceinline__ void gemm_phase(PG8_LAS unsigned char* lds, const Gemm g, const Sched& S, const Epi& E) {
    const int tid = (int)threadIdx.x + opaque_zero(), wid = __builtin_amdgcn_readfirstlane(tid >> 6), lane = tid & 63, wr = wid >> 2, wc = wid & 3, fr = lane & 15, fq = lane >> 4;
    const int K = g.K, nt = K / BK, lda = g.lda ? g.lda : g.K;
    unsigned voffA[2], voffB[2];
#pragma unroll
    for (int i = 0; i < 2; ++i) { int R, C; stage_rc(tid * 16 + i * 8192, R, C); const int Rb = Epi::PERM ? ((R & ~31) + perm32(R & 31)) : R;
        voffA[i] = (unsigned)(R * lda + C) * 2u; voffB[i] = (unsigned)(Rb * K + C) * 2u; }
    const size_t kstep = (size_t)(BK * 2);
    const size_t hstepA = (size_t)HALF * lda * 2, hstepB = (size_t)HALF * K * 2;
    const size_t tstepA = 2 * hstepA, tstepB = 2 * hstepB;
    const unsigned ldsw = (unsigned)wid * 1024u;
    const int aoff = lds_byte(wr * 64 + fr, fq * 8), boff = lds_byte(wc * 32 + fr, fq * 8);
#define PG8_SA(b, h) (((b) * 2 + (h)) * HTB)
#define PG8_SB(b, h) ((4 + (b) * 2 + (h)) * HTB)
#define PG8_STAGE(bufoff, gbase, voff) do { _Pragma("unroll") for (int _i = 0; _i < 2; ++_i) \
        __builtin_amdgcn_global_load_lds((const unsigned*)((const char*)(gbase) + (voff)[_i]), (PG8_LAS unsigned*)(lds + (bufoff) + ldsw + _i * 8192), 16, 0, 0); } while (0)
#define PG8_LDA(dst, b, h) do { _Pragma("unroll") for (int m = 0; m < 4; ++m) _Pragma("unroll") for (int k = 0; k < 2; ++k) dst[m][k] = *(const PG8_LAS bf16x8*)(lds + PG8_SA(b, h) + aoff + m * 2048 + k * 1024); } while (0)
#define PG8_LDB(dst, b, h) do { _Pragma("unroll") for (int n = 0; n < 2; ++n) _Pragma("unroll") for (int k = 0; k < 2; ++k) dst[n][k] = *(const PG8_LAS bf16x8*)(lds + PG8_SB(b, h) + boff + n * 2048 + k * 1024); } while (0)
#define PG8_MMA(ai, bj, At, Bt) do { __builtin_amdgcn_s_setprio(1); _Pragma("unroll") for (int m = 0; m < 4; ++m) _Pragma("unroll") for (int n = 0; n < 2; ++n) _Pragma("unroll") for (int k = 0; k < 2; ++k) \
        acc[ai][bj][m][n] = __builtin_amdgcn_mfma_f32_16x16x32_bf16(Bt[n][k], At[m][k], acc[ai][bj][m][n], 0, 0, 0); __builtin_amdgcn_s_setprio(0); } while (0)
#define PG8_WAIT_V(n) asm volatile("s_waitcnt vmcnt(" #n ")" ::: "memory")
#define PG8_WAIT_L(n) asm volatile("s_waitcnt lgkmcnt(" #n ")" ::: "memory")
#define PG8_BAR __builtin_amdgcn_s_barrier()
#define PG8_SCHED __builtin_amdgcn_sched_barrier(0)
    Unit cur, nxt; int ui = 0;
    if (!S.next(0, cur)) return;
    f32x4 acc[2][2][4][2];
#pragma unroll
    for (int a = 0; a < 2; ++a)
#pragma unroll
        for (int b = 0; b < 2; ++b)
#pragma unroll
            for (int m = 0; m < 4; ++m)
#pragma unroll
                for (int n = 0; n < 2; ++n) acc[a][b][m][n] = (f32x4){0.f, 0.f, 0.f, 0.f};
    bf16x8 At[4][2], B0[2][2], B1[2][2];
    const char* cA = (const char*)g.A + (size_t)cur.pm * tstepA; const char* cB = (const char*)g.Bt + (size_t)cur.pn * tstepB;
    S.a_ready(cur);
    if constexpr (SP2) {
        PG8_STAGE(PG8_SB(0, 0), cB, voffB); PG8_STAGE(PG8_SB(0, 1), cB + hstepB, voffB); PG8_STAGE(PG8_SA(0, 0), cA, voffA); PG8_STAGE(PG8_SA(0, 1), cA + hstepA, voffA);
        if (wr == 1) PG8_BAR;
        PG8_WAIT_V(2); PG8_BAR;
        PG8_STAGE(PG8_SB(1, 0), cB + kstep, voffB); PG8_STAGE(PG8_SA(1, 0), cA + kstep, voffA); PG8_STAGE(PG8_SB(1, 1), cB + hstepB + kstep, voffB);
        PG8_WAIT_V(6); PG8_BAR;
    } else {
        PG8_STAGE(PG8_SB(0, 0), cB, voffB); PG8_STAGE(PG8_SA(0, 0), cA, voffA); PG8_STAGE(PG8_SB(0, 1), cB + hstepB, voffB); PG8_STAGE(PG8_SA(0, 1), cA + hstepA, voffA);
        if (wr == 1) PG8_BAR;
        PG8_WAIT_V(4); PG8_BAR;
        PG8_STAGE(PG8_SB(1, 0), cB + kstep, voffB); PG8_STAGE(PG8_SA(1, 0), cA + kstep, voffA); PG8_STAGE(PG8_SB(1, 1), cB + hstepB + kstep, voffB);
        PG8_WAIT_V(6); PG8_BAR;
    }
    for (;;) {
        const bool has_next = S.next(ui + 1, nxt);
        const char* nA = has_next ? (const char*)g.A + (size_t)nxt.pm * tstepA : cA; const char* nB = has_next ? (const char*)g.Bt + (size_t)nxt.pn * tstepB : cB;
        for (int t = 0; t < nt; t += 2) {
            const bool last = (t == nt - 2);
            const char* a1 = cA + (size_t)(t + 1) * kstep;
            const char* a2 = last ? nA : cA + (size_t)(t + 2) * kstep; const char* b2 = last ? nB : cB + (size_t)(t + 2) * kstep;
            const char* a3 = a2 + kstep; const char* b3 = b2 + kstep;
            if (last && has_next) S.a_ready(nxt);
            if constexpr (SP2) {
            PG8_LDB(B0, 0, 0); PG8_LDB(B1, 0, 1); PG8_SCHED; PG8_LDA(At, 0, 0); PG8_STAGE(PG8_SA(1, 1), a1 + hstepA, voffA);
            PG8_WAIT_V(8); PG8_WAIT_L(0); PG8_BAR; PG8_MMA(0, 0, At, B0); PG8_MMA(0, 1, At, B1); PG8_BAR; PG8_SCHED;
            PG8_LDA(At, 0, 1); PG8_STAGE(PG8_SB(0, 0), b2, voffB); PG8_STAGE(PG8_SB(0, 1), b2 + hstepB, voffB); PG8_STAGE(PG8_SA(0, 0), a2, voffA);
            PG8_WAIT_V(8); PG8_WAIT_L(0); PG8_BAR; PG8_MMA(1, 0, At, B0); PG8_MMA(1, 1, At, B1); PG8_BAR; PG8_SCHED;
            PG8_LDB(B0, 1, 0); PG8_LDB(B1, 1, 1); PG8_SCHED; PG8_LDA(At, 1, 0); PG8_STAGE(PG8_SA(0, 1), a2 + hstepA, voffA);
            PG8_WAIT_V(8); PG8_WAIT_L(0); PG8_BAR; PG8_MMA(0, 0, At, B0); PG8_MMA(0, 1, At, B1); PG8_BAR; PG8_SCHED;
            PG8_LDA(At, 1, 1); PG8_STAGE(PG8_SB(1, 0), b3, voffB); PG8_STAGE(PG8_SB(1, 1), b3 + hstepB, voffB); PG8_STAGE(PG8_SA(1, 0), a3, voffA);
            PG8_WAIT_V(8); PG8_WAIT_L(0); PG8_BAR; PG8_MMA(1, 0, At, B0); PG8_MMA(1, 1, At, B1); PG8_BAR; PG8_SCHED;
            } else {
            PG8_LDB(B0, 0, 0); PG8_SCHED; PG8_LDA(At, 0, 0); PG8_STAGE(PG8_SA(1, 1), a1 + hstepA, voffA);
            PG8_WAIT_L(8); PG8_BAR; PG8_WAIT_L(0); PG8_MMA(0, 0, At, B0); PG8_BAR; PG8_SCHED;
            PG8_LDB(B1, 0, 1); PG8_STAGE(PG8_SB(0, 0), b2, voffB);
            PG8_BAR; PG8_WAIT_L(0); PG8_MMA(0, 1, At, B1); PG8_BAR;
            PG8_LDA(At, 0, 1); PG8_STAGE(PG8_SA(0, 0), a2, voffA);
            PG8_BAR; PG8_WAIT_L(0); PG8_MMA(1, 0, At, B0); PG8_BAR; PG8_SCHED;
            PG8_STAGE(PG8_SB(0, 1), b2 + hstepB, voffB);
            PG8_WAIT_V(6); PG8_BAR; PG8_MMA(1, 1, At, B1); PG8_BAR;
            PG8_LDB(B0, 1, 0); PG8_SCHED; PG8_LDA(At, 1, 0); PG8_STAGE(PG8_SA(0, 1), a2 + hstepA, voffA);
            PG8_WAIT_L(8); PG8_BAR; PG8_WAIT_L(0); PG8_MMA(0, 0, At, B0); PG8_BAR; PG8_SCHED;
            PG8_LDB(B1, 1, 1); PG8_STAGE(PG8_SB(1, 0), b3, voffB);
            PG8_BAR; PG8_WAIT_L(0); PG8_MMA(0, 1, At, B1); PG8_BAR;
            PG8_LDA(At, 1, 1); PG8_STAGE(PG8_SA(1, 0), a3, voffA);
            PG8_BAR; PG8_WAIT_L(0); PG8_MMA(1, 0, At, B0); PG8_BAR; PG8_SCHED;
            PG8_STAGE(PG8_SB(1, 1), b3 + hstepB, voffB);
            PG8_WAIT_V(6); PG8_BAR; PG8_MMA(1, 1, At, B1); PG8_BAR;
            }
        }
        if constexpr (ALIGN_EPI) { if (wr == 0) PG8_BAR; }
        if constexpr (!Epi::AFTER_DRAIN) { E(acc, cur, wr, wc, fr, fq); S.done(cur); }
        if (!has_next) break;
#pragma unroll
        for (int a = 0; a < 2; ++a)
#pragma unroll
            for (int b = 0; b < 2; ++b)
#pragma unroll
                for (int m = 0; m < 4; ++m)
#pragma unroll
                    for (int n = 0; n < 2; ++n) acc[a][b][m][n] = (f32x4){0.f, 0.f, 0.f, 0.f};
        cur = nxt; cA = nA; cB = nB; ++ui;
        if constexpr (ALIGN_EPI) { if (wr == 1) PG8_BAR; }
    }
    PG8_WAIT_V(0);
    if constexpr (!ALIGN_EPI) { if (wr == 0) PG8_BAR; }
    PG8_BAR;
    if constexpr (Epi::AFTER_DRAIN) { E.fused(acc, cur, wr, wc, fr, fq, lds, wid, lane); S.done(cur); }
#undef PG8_SA
#undef PG8_SB
#undef PG8_STAGE
#undef PG8_LDA
#undef PG8_LDB
#undef PG8_MMA
#undef PG8_WAIT_V
#undef PG8_WAIT_L
#undef PG8_BAR
#undef PG8_SCHED
}
}

#define LAS __attribute__((address_space(3)))
typedef unsigned short bf16_t;
typedef short bf16x8 __attribute__((ext_vector_type(8)));
typedef short bf16x4 __attribute__((ext_vector_type(4)));
typedef float f32x4 __attribute__((ext_vector_type(4)));
typedef float f32x16 __attribute__((ext_vector_type(16)));
typedef unsigned u32x4 __attribute__((ext_vector_type(4)));
typedef unsigned u32x2 __attribute__((ext_vector_type(2)));

constexpr int NB = 4, SEQ = 4096, DM = 2048, DEPTH = 4, MTOK = NB * SEQ;
constexpr int IN_W = 5896, NPAD = 6144, LDP = NPAD + 64, MIXW = 2048;
constexpr int C_MQ = 0, C_MK = 512, C_MV = 1024, C_MG = 1536, C_XBC = 2048, C_Z = 3072, C_SQ = 3584, C_SK = 4096, C_SV = 4224,
              C_SG = 4352, C_SU = 4864, C_S5G = 5376, C_DT = 5888;
constexpr float NORM_EPS = 1e-6f;
constexpr float LOG2E = 1.4426950408889634f;
constexpr float QSCALE = 0.125f * LOG2E;

constexpr size_t SZ_WIN = (size_t)DEPTH * NPAD * DM * 2, SZ_WOUT = (size_t)DEPTH * DM * MIXW * 2, SZ_GLU = (size_t)DEPTH * 512 * 512 * 2;
constexpr size_t WS_WIN = 0;
constexpr size_t WS_WOUT = WS_WIN + SZ_WIN;
constexpr size_t WS_GLU = WS_WOUT + SZ_WOUT;
constexpr size_t WS_H = WS_GLU + SZ_GLU;
constexpr size_t WS_MIX = WS_H + (size_t)MTOK * DM * 2;
constexpr size_t WS_PROJ = WS_MIX + (size_t)MTOK * MIXW * 2;
constexpr size_t WS_XC = WS_PROJ + (size_t)MTOK * LDP * 2;
constexpr int TP = SEQ + 64;
constexpr size_t WS_XDT = WS_XC + (size_t)MTOK * 1024 * 2;
constexpr size_t WS_BT = WS_XDT + (size_t)NB * 8 * 64 * TP * 2;
constexpr size_t WS_MVT = WS_BT + (size_t)NB * 2 * 128 * TP * 2;
constexpr size_t WS_SVT = WS_MVT + (size_t)NB * 8 * 64 * TP * 2;
constexpr size_t WS_DTV = WS_SVT + (size_t)NB * 2 * 64 * TP * 2;
constexpr size_t WS_ACUM = WS_DTV + (size_t)NB * 8 * SEQ * 4;
constexpr size_t WS_CS = WS_ACUM + (size_t)NB * 8 * SEQ * 4;
constexpr size_t WS_KMEAN = WS_CS + (size_t)NB * 16 * 8 * 8192 * 4;
constexpr size_t WS_S5E = WS_KMEAN + (size_t)NB * 8 * 16 * 64 * 4;
constexpr size_t WS_S5Y = WS_S5E + (size_t)NB * 32 * 16 * 64 * 8;
constexpr int S5YP = 576;
constexpr size_t WS_ROPE = WS_S5Y + (size_t)MTOK * S5YP * 2;
constexpr size_t WS_BAR = WS_ROPE + (size_t)SEQ * 32 * 4 * 2;
constexpr size_t WS_XBAR = WS_BAR + 1024;
constexpr size_t WS_XR = WS_XBAR + 16384;
constexpr size_t WS_END = WS_XR + (size_t)MTOK * DM * 2;

constexpr int LDS_BYTES = 144 * 1024;

struct P {
  const float *x, *pre_norm, *post_norm, *w_in, *w_out, *conv_w, *conv_b, *dt_bias, *a_log, *ssd_d, *ssd_norm, *sinks,
      *a_re, *a_im, *log_dt, *b_re, *b_im, *c_re, *c_im, *s5_d, *glu_w, *glu_b;
  float* out; unsigned char* ws;
};

typedef const __attribute__((address_space(4))) P* KP;
__device__ __forceinline__ P load_params(unsigned long long a) {
  asm volatile("" : "+s"(a));
  KP q = (KP)a;
  P p;
  p.x = q->x; p.pre_norm = q->pre_norm; p.post_norm = q->post_norm; p.w_in = q->w_in; p.w_out = q->w_out; p.conv_w = q->conv_w; p.conv_b = q->conv_b;
  p.dt_bias = q->dt_bias; p.a_log = q->a_log; p.ssd_d = q->ssd_d; p.ssd_norm = q->ssd_norm; p.sinks = q->sinks; p.a_re = q->a_re; p.a_im = q->a_im;
  p.log_dt = q->log_dt; p.b_re = q->b_re; p.b_im = q->b_im; p.c_re = q->c_re; p.c_im = q->c_im; p.s5_d = q->s5_d; p.glu_w = q->glu_w; p.glu_b = q->glu_b;
  p.out = q->out; p.ws = q->ws;
  return p;
}

__device__ __forceinline__ float bf2f(unsigned short v) { return __builtin_bit_cast(float, (unsigned)v << 16); }
__device__ __forceinline__ float bflo(unsigned w) { return __builtin_bit_cast(float, w << 16); }
__device__ __forceinline__ float bfhi(unsigned w) { return __builtin_bit_cast(float, w & 0xffff0000u); }
__device__ __forceinline__ unsigned short f2bf(float f) { unsigned u = __builtin_bit_cast(unsigned, f); return (unsigned short)((u + 0x7fffu + ((u >> 16) & 1u)) >> 16); }
__device__ __forceinline__ unsigned pk2(float lo, float hi) { return pg8::cvt_pk_bf16(lo, hi); }
__device__ __forceinline__ float wave_sum(float v) {
#pragma unroll
  for (int o = 1; o < 64; o <<= 1) v += __shfl_xor(v, o);
  return v;
}
__device__ __forceinline__ float fexp2(float x) { return __builtin_amdgcn_exp2f(x); }
__device__ __forceinline__ float fexp(float x) { return __builtin_amdgcn_exp2f(x * LOG2E); }
__device__ __forceinline__ float silu_f(float x) { return x * __builtin_amdgcn_rcpf(1.f + fexp(-x)); }
__device__ __forceinline__ float sigmoid_f(float x) { return __builtin_amdgcn_rcpf(1.f + fexp(-x)); }
__device__ __forceinline__ float softplus_f(float x) {
  const float e = fexp(-fabsf(x));
  const float l = (e < 0.03125f) ? e * (1.f - e * (0.5f - e * (0.33333333f - 0.25f * e))) : __logf(1.f + e);
  return fmaxf(x, 0.f) + l;
}
__device__ __forceinline__ float gelu_tanh_f(float x) {
  const float u = 0.7978845608028654f * (x + 0.044715f * x * x * x);
  const float t = 1.f - 2.f * __builtin_amdgcn_rcpf(1.f + fexp(2.f * u));
  return 0.5f * x * (1.f + t);
}
#define MFMA32(a, b, c) __builtin_amdgcn_mfma_f32_32x32x16_bf16((a), (b), (c), 0, 0, 0)
__device__ __forceinline__ int crow(int reg, int hf) { return (reg & 3) + 8 * (reg >> 2) + 4 * hf; }

__device__ __forceinline__ int il64(int j) { return ((j & 1) << 5) + (j >> 1); }
__device__ __forceinline__ int map_in_col(int n) {
  if (n < 1024) return (n & ~63) + il64(n & 63);
  if (n < 3072) return n;
  if (n < C_SQ) return n + 8;
  if (n < C_SV) { const int q = n - C_SQ; return 3592 + (q & ~63) + il64(q & 63); }
  if (n < C_DT) return n + 8;
  if (n < C_DT + 8) return 3072 + (n - C_DT);
  return -1;
}

__device__ __forceinline__ void transpose_item(const float* W, int K, int N, bf16_t* WT, int n0, int k0, bool mapped, LAS float* scr, int lane) {
  const int nl = lane & 31;
  const int nsrc = mapped ? map_in_col(n0 + nl) : (n0 + nl);
  float wv_[32];
#pragma unroll
  for (int i = 0; i < 32; ++i) { const int kk = 2 * i + (lane >> 5); wv_[i] = nsrc >= 0 ? W[(size_t)(k0 + kk) * N + nsrc] : 0.f; }
#pragma unroll
  for (int i = 0; i < 32; ++i) { const int kk = 2 * i + (lane >> 5); scr[kk * 33 + nl] = wv_[i]; }
  asm volatile("s_waitcnt lgkmcnt(0)" ::: "memory");
  const int c = lane & 7;
#pragma unroll
  for (int j = 0; j < 4; ++j) { const int n = (lane >> 3) + 8 * j; const LAS float* s = scr + (8 * c) * 33 + n;
    u32x4 o; o.x = pk2(s[0 * 33], s[1 * 33]); o.y = pk2(s[2 * 33], s[3 * 33]); o.z = pk2(s[4 * 33], s[5 * 33]); o.w = pk2(s[6 * 33], s[7 * 33]);
    *(u32x4*)(WT + (size_t)(n0 + n) * K + k0 + 8 * c) = o; }
  asm volatile("s_waitcnt lgkmcnt(0)" ::: "memory");
}

__device__ __forceinline__ void prenorm_row(const float* xrow, const float* g, bf16_t* hrow, int lane) {
  f32x4 v[8]; float ss = 0.f;
#pragma unroll
  for (int j = 0; j < 8; ++j) { v[j] = *(const f32x4*)(xrow + 4 * lane + 256 * j); ss += v[j].x * v[j].x + v[j].y * v[j].y + v[j].z * v[j].z + v[j].w * v[j].w; }
  const float rstd = 1.f / sqrtf(wave_sum(ss) * (1.f / DM) + NORM_EPS);
#pragma unroll
  for (int j = 0; j < 8; ++j) { const f32x4 gg = *(const f32x4*)(g + 4 * lane + 256 * j);
    u32x2 o; o.x = pk2(v[j].x * rstd * gg.x, v[j].y * rstd * gg.y); o.y = pk2(v[j].z * rstd * gg.z, v[j].w * rstd * gg.w);
    *(u32x2*)(hrow + 4 * lane + 256 * j) = o; }
}

__device__ __forceinline__ void phase0(const P& p, LAS unsigned char* lds, int tid, int lane, int wave) {
  LAS float* scr = (LAS float*)(lds + wave * 16384);
  const int gw = blockIdx.x * 8 + wave, NGW = gridDim.x * 8;
  bf16_t* WIN = (bf16_t*)(p.ws + WS_WIN); bf16_t* WOUT = (bf16_t*)(p.ws + WS_WOUT); bf16_t* GLU = (bf16_t*)(p.ws + WS_GLU);
  constexpr int I_IN = (DM / 64) * (NPAD / 32), I_OUT = (MIXW / 64) * (DM / 32), I_GLU = (512 / 64) * (512 / 32), I_L = I_IN + I_OUT + I_GLU;
  for (int it = gw; it < DEPTH * I_L; it += NGW) {
    const int l = it / I_L; int r = it % I_L;
    if (r < I_IN) { const int nb = r % (NPAD / 32), kb = r / (NPAD / 32);
      transpose_item(p.w_in + (size_t)l * DM * IN_W, DM, IN_W, WIN + (size_t)l * NPAD * DM, nb * 32, kb * 64, true, scr, lane); continue; }
    r -= I_IN;
    if (r < I_OUT) { const int nb = r % (DM / 32), kb = r / (DM / 32);
      transpose_item(p.w_out + (size_t)l * MIXW * DM, MIXW, DM, WOUT + (size_t)l * DM * MIXW, nb * 32, kb * 64, false, scr, lane); continue; }
    r -= I_OUT;
    { const int nb = r % 16, kb = r / 16;
      transpose_item(p.glu_w + (size_t)l * 512 * 512, 512, 512, GLU + (size_t)l * 512 * 512, nb * 32, kb * 64, false, scr, lane); }
  }
  float* rc = (float*)(p.ws + WS_ROPE); float* rs = rc + SEQ * 32;
  for (int i = blockIdx.x * 512 + tid; i < SEQ * 32; i += gridDim.x * 512) {
    const int pos = i >> 5, f = i & 31;
    const float inv = 1.0f / powf(10000.f, (float)(2 * f) / 64.f);
    const float ang = (float)pos * inv;
    rc[i] = cosf(ang); rs[i] = sinf(ang);
  }
  bf16_t* H = (bf16_t*)(p.ws + WS_H);
  for (int m = gw; m < MTOK; m += 2 * NGW) {
    const float* x0 = p.x + (size_t)m * DM; const float* x1 = p.x + (size_t)(m + NGW) * DM;
    f32x4 v0[8], v1[8]; float s0 = 0.f, s1 = 0.f;
#pragma unroll
    for (int j = 0; j < 8; ++j) { v0[j] = *(const f32x4*)(x0 + 4 * lane + 256 * j); v1[j] = *(const f32x4*)(x1 + 4 * lane + 256 * j); }
#pragma unroll
    for (int j = 0; j < 8; ++j) { s0 += v0[j].x * v0[j].x + v0[j].y * v0[j].y + v0[j].z * v0[j].z + v0[j].w * v0[j].w; s1 += v1[j].x * v1[j].x + v1[j].y * v1[j].y + v1[j].z * v1[j].z + v1[j].w * v1[j].w; }
    const float r0 = 1.f / sqrtf(wave_sum(s0) * (1.f / DM) + NORM_EPS), r1 = 1.f / sqrtf(wave_sum(s1) * (1.f / DM) + NORM_EPS);
#pragma unroll
    for (int j = 0; j < 8; ++j) { const f32x4 gg = *(const f32x4*)(p.pre_norm + 4 * lane + 256 * j);
      u32x2 o0, o1; o0.x = pk2(v0[j].x * r0 * gg.x, v0[j].y * r0 * gg.y); o0.y = pk2(v0[j].z * r0 * gg.z, v0[j].w * r0 * gg.w);
      o1.x = pk2(v1[j].x * r1 * gg.x, v1[j].y * r1 * gg.y); o1.y = pk2(v1[j].z * r1 * gg.z, v1[j].w * r1 * gg.w);
      *(u32x2*)(H + (size_t)m * DM + 4 * lane + 256 * j) = o0; *(u32x2*)(H + (size_t)(m + NGW) * DM + 4 * lane + 256 * j) = o1; }
  }
}

struct EpiProj {
  static constexpr bool PERM = true, AFTER_DRAIN = false;
  bf16_t* O; const float* rc; const float* rs;
  __device__ __forceinline__ void operator()(const pg8::f32x4 (&acc)[2][2][4][2], const pg8::Unit& u, int wr, int wc, int fr_, int fq_) const {
    const int ln = (int)(threadIdx.x & 63) + opaque_zero(); const int fr = ln & 15, fq = ln >> 4;
    const int row0 = u.pm * 256 + wr * 64 + fr;
#pragma unroll
    for (int bj = 0; bj < 2; ++bj) {
      const int cb = u.pn * 256 + bj * 128;
      int mode = 0;
      if (cb < C_MK) mode = 2; else if (cb < C_MV) mode = 1; else if (cb >= C_SQ && cb < C_SK) mode = 2; else if (cb >= C_SK && cb < C_SV) mode = 1;
      const int col0 = cb + wc * 32 + 8 * fq;
      const int i0 = 16 * (wc & 1) + 4 * fq;
#pragma unroll
      for (int ai = 0; ai < 2; ++ai)
#pragma unroll
        for (int m = 0; m < 4; ++m) {
          const int row = row0 + ai * 128 + m * 16;
          f32x4 v0 = acc[ai][bj][m][0], v1 = acc[ai][bj][m][1];
          if (mode) {
            const int pos = row & (SEQ - 1);
            const f32x4 c = *(const f32x4*)(rc + pos * 32 + i0), s = *(const f32x4*)(rs + pos * 32 + i0);
            const float sc = (mode == 2) ? QSCALE : 1.f;
            f32x4 a, b;
            a[0] = (v0[0] * c[0] - v0[1] * s[0]) * sc; a[1] = (v0[1] * c[0] + v0[0] * s[0]) * sc;
            a[2] = (v0[2] * c[1] - v0[3] * s[1]) * sc; a[3] = (v0[3] * c[1] + v0[2] * s[1]) * sc;
            b[0] = (v1[0] * c[2] - v1[1] * s[2]) * sc; b[1] = (v1[1] * c[2] + v1[0] * s[2]) * sc;
            b[2] = (v1[2] * c[3] - v1[3] * s[3]) * sc; b[3] = (v1[3] * c[3] + v1[2] * s[3]) * sc;
            v0 = a; v1 = b;
          }
          u32x4 w; w.x = pk2(v0[0], v0[1]); w.y = pk2(v0[2], v0[3]); w.z = pk2(v1[0], v1[1]); w.w = pk2(v1[2], v1[3]);
          *(u32x4*)(O + (size_t)row * LDP + col0) = w;
        }
    }
  }
};

struct EpiYo {
  static constexpr bool PERM = true, AFTER_DRAIN = false;
  bf16_t* O; int ldc;
  __device__ __forceinline__ void operator()(const pg8::f32x4 (&acc)[2][2][4][2], const pg8::Unit& u, int wr, int wc, int fr_, int fq_) const {
    const int ln = (int)(threadIdx.x & 63) + opaque_zero(); const int fr = ln & 15, fq = ln >> 4;
    const int row0 = u.pm * 256 + wr * 64 + fr;
#pragma unroll
    for (int ai = 0; ai < 2; ++ai)
#pragma unroll
      for (int m = 0; m < 4; ++m) {
        bf16_t* rp = O + (size_t)(row0 + ai * 128 + m * 16) * ldc + u.pn * 256 + wc * 32 + 8 * fq;
#pragma unroll
        for (int bj = 0; bj < 2; ++bj) { const pg8::f32x4 v0 = acc[ai][bj][m][0], v1 = acc[ai][bj][m][1];
          u32x4 w; w.x = pk2(v0[0], v0[1]); w.y = pk2(v0[2], v0[3]); w.z = pk2(v1[0], v1[1]); w.w = pk2(v1[2], v1[3]);
          *(u32x4*)(rp + bj * 128) = w; }
      }
  }
};

struct EpiGlu {
  static constexpr bool PERM = true, AFTER_DRAIN = false;
  bf16_t* MIX; const bf16_t* Y; const bf16_t* PROJ; const float* bias;
  __device__ __forceinline__ void operator()(const pg8::f32x4 (&acc)[2][2][4][2], const pg8::Unit& u, int wr, int wc, int fr_, int fq_) const {
    const int ln = (int)(threadIdx.x & 63) + opaque_zero(); const int fr = ln & 15, fq = ln >> 4;
    const int row0 = u.pm * 256 + wr * 64 + fr;
#pragma unroll
    for (int bj = 0; bj < 2; ++bj) {
      const int col0 = u.pn * 256 + bj * 128 + wc * 32 + 8 * fq;
      const f32x4 b0 = *(const f32x4*)(bias + col0), b1 = *(const f32x4*)(bias + col0 + 4);
#pragma unroll
      for (int ai = 0; ai < 2; ++ai)
#pragma unroll
        for (int m = 0; m < 4; ++m) {
          const int row = row0 + ai * 128 + m * 16;
          bf16_t* mp = MIX + (size_t)row * MIXW + 1536 + col0;
          const u32x4 mv = *(const u32x4*)mp;
          const f32x4 a0 = acc[ai][bj][m][0] + b0, a1 = acc[ai][bj][m][1] + b1;
          u32x4 w;
          w.x = pk2(bflo(mv.x) * sigmoid_f(a0[0]), bfhi(mv.x) * sigmoid_f(a0[1])); w.y = pk2(bflo(mv.y) * sigmoid_f(a0[2]), bfhi(mv.y) * sigmoid_f(a0[3]));
          w.z = pk2(bflo(mv.z) * sigmoid_f(a1[0]), bfhi(mv.z) * sigmoid_f(a1[1])); w.w = pk2(bflo(mv.w) * sigmoid_f(a1[2]), bfhi(mv.w) * sigmoid_f(a1[3]));
          *(u32x4*)mp = w;
        }
    }
  }
};

struct OneUnit {
  int pm, pn;
  __device__ __forceinline__ bool next(int i, pg8::Unit& u) const { if (i != 0) return false; u.pm = pm; u.pn = pn; return true; }
  __device__ __forceinline__ void a_ready(const pg8::Unit&) const {}
  __device__ __forceinline__ void done(const pg8::Unit&) const {}
};
__device__ __forceinline__ void unpack8(const u32x4 v, float (&f)[8]) {
  f[0] = bflo(v.x); f[1] = bfhi(v.x); f[2] = bflo(v.y); f[3] = bfhi(v.y); f[4] = bflo(v.z); f[5] = bfhi(v.z); f[6] = bflo(v.w); f[7] = bfhi(v.w);
}
__device__ __forceinline__ void conv_unit(const P& p, int layer, int rt, int cb, int lane, int wv) {
  const bf16_t* PROJ = (const bf16_t*)(p.ws + WS_PROJ); bf16_t* XC = (bf16_t*)(p.ws + WS_XC);
  const int col0 = cb * 512 + lane * 8, g0 = rt * 64 + wv * 8, b = g0 >> 12, t0 = g0 & (SEQ - 1);
  const float* cw = p.conv_w + (size_t)layer * 4 * 1024 + col0;
  float w0[8], w1[8], w2[8], w3[8], cbv[8];
  { const f32x4 a0 = *(const f32x4*)cw, a1 = *(const f32x4*)(cw + 4), b0 = *(const f32x4*)(cw + 1024), b1 = *(const f32x4*)(cw + 1028),
      c0 = *(const f32x4*)(cw + 2048), c1 = *(const f32x4*)(cw + 2052), d0 = *(const f32x4*)(cw + 3072), d1 = *(const f32x4*)(cw + 3076);
    const f32x4 e0 = *(const f32x4*)(p.conv_b + layer * 1024 + col0), e1 = *(const f32x4*)(p.conv_b + layer * 1024 + col0 + 4);
#pragma unroll
    for (int e = 0; e < 4; ++e) { w0[e] = a0[e]; w0[4 + e] = a1[e]; w1[e] = b0[e]; w1[4 + e] = b1[e]; w2[e] = c0[e]; w2[4 + e] = c1[e]; w3[e] = d0[e]; w3[4 + e] = d1[e]; cbv[e] = e0[e]; cbv[4 + e] = e1[e]; } }
  const bf16_t* src = PROJ + (size_t)g0 * LDP + C_XBC + col0;
  float xm3[8], xm2[8], xm1[8];
#pragma unroll
  for (int e = 0; e < 8; ++e) { xm3[e] = 0.f; xm2[e] = 0.f; xm1[e] = 0.f; }
  if (t0 > 0) { unpack8(*(const u32x4*)(src - 3 * LDP), xm3); unpack8(*(const u32x4*)(src - 2 * LDP), xm2); unpack8(*(const u32x4*)(src - 1 * LDP), xm1); }
  const int h = col0 >> 6;
  float dtb = 0.f; if (cb == 0) dtb = p.dt_bias[layer * 8 + h];
  unsigned outp[8][4];
#pragma unroll
  for (int i = 0; i < 8; ++i) {
    float x0[8]; unpack8(*(const u32x4*)(src + (size_t)i * LDP), x0);
    float dt = 1.f;
    if (cb == 0) dt = softplus_f(bf2f(PROJ[(size_t)(g0 + i) * LDP + C_DT + h]) + dtb);
    float v[8];
#pragma unroll
    for (int e = 0; e < 8; ++e) { v[e] = silu_f(w0[e] * xm3[e] + w1[e] * xm2[e] + w2[e] * xm1[e] + w3[e] * x0[e] + cbv[e]); xm3[e] = xm2[e]; xm2[e] = xm1[e]; xm1[e] = x0[e]; }
    u32x4 o; o.x = pk2(v[0], v[1]); o.y = pk2(v[2], v[3]); o.z = pk2(v[4], v[5]); o.w = pk2(v[6], v[7]);
    *(u32x4*)(XC + (size_t)(g0 + i) * 1024 + col0) = o;
#pragma unroll
    for (int e = 0; e < 8; ++e) { const unsigned q = f2bf(v[e] * dt); if (i & 1) outp[e][i >> 1] |= (q << 16); else outp[e][i >> 1] = q; }
  }
  bf16_t* dst = nullptr;
  if (cb == 0) dst = (bf16_t*)(p.ws + WS_XDT) + ((size_t)(b * 8 + h) * 64 + (col0 & 63)) * TP + t0;
  else if (lane < 32) dst = (bf16_t*)(p.ws + WS_BT) + ((size_t)(b * 2 + (lane >> 4)) * 128 + ((lane * 8) & 127)) * TP + t0;
  if (dst) {
#pragma unroll
    for (int e = 0; e < 8; ++e) {
      u32x4 o0; o0.x = outp[e][0]; o0.y = outp[e][1]; o0.z = outp[e][2]; o0.w = outp[e][3];
      *(u32x4*)(dst + (size_t)e * TP) = o0; }
  }
}
template <int NR>
__device__ __forceinline__ void vtrans_tile(const P& p, int g0, int cbase, int c0, int nh, bf16_t* VT) {
  const bf16_t* PROJ = (const bf16_t*)(p.ws + WS_PROJ);
  const int b = g0 >> 12, t0 = g0 & (SEQ - 1);
  const bf16_t* src = PROJ + (size_t)g0 * LDP + cbase + c0;
  unsigned outp[8][NR / 2];
#pragma unroll
  for (int i = 0; i < NR; ++i) { const u32x4 v = *(const u32x4*)(src + (size_t)i * LDP);
    const unsigned q[8] = {v.x & 0xffffu, v.x >> 16, v.y & 0xffffu, v.y >> 16, v.z & 0xffffu, v.z >> 16, v.w & 0xffffu, v.w >> 16};
#pragma unroll
    for (int e = 0; e < 8; ++e) { if (i & 1) outp[e][i >> 1] |= (q[e] << 16); else outp[e][i >> 1] = q[e]; } }
  bf16_t* dst = VT + ((size_t)(b * nh + (c0 >> 6)) * 64 + (c0 & 63)) * TP + t0;
#pragma unroll
  for (int e = 0; e < 8; ++e)
#pragma unroll
    for (int j = 0; j < NR / 8; ++j) { u32x4 o; o.x = outp[e][4 * j]; o.y = outp[e][4 * j + 1]; o.z = outp[e][4 * j + 2]; o.w = outp[e][4 * j + 3]; *(u32x4*)(dst + (size_t)e * TP + 8 * j) = o; }
}
__device__ __forceinline__ void dtscan_unit(const P& p, int layer, int u, int lane, int wave  ) {
  const bf16_t* PROJ = (const bf16_t*)(p.ws + WS_PROJ);
  const int b = u >> 4, c = u & 15, h = wave;
  const float dtb = p.dt_bias[layer * 8 + h], A = -expf(p.a_log[layer * 8 + h]);
  const int t = c * 256 + 4 * lane;
  float dt[4], a[4];
#pragma unroll
  for (int i = 0; i < 4; ++i) { dt[i] = softplus_f(bf2f(PROJ[(size_t)(b * SEQ + t + i) * LDP + C_DT + h]) + dtb); a[i] = dt[i] * A; }
  a[1] += a[0]; a[2] += a[1]; a[3] += a[2];
  float incl = a[3];
#pragma unroll
  for (int o = 1; o < 64; o <<= 1) { const float v = __shfl_up(incl, o); if (lane >= o) incl += v; }
  const float excl = incl - a[3];
  float* DTV = (float*)(p.ws + WS_DTV) + (size_t)(b * 8 + h) * SEQ + t; float* AC = (float*)(p.ws + WS_ACUM) + (size_t)(b * 8 + h) * SEQ + t;
  *(f32x4*)DTV = (f32x4){dt[0], dt[1], dt[2], dt[3]};
  *(f32x4*)AC = (f32x4){a[0] + excl, a[1] + excl, a[2] + excl, a[3] + excl};
}
__device__ __forceinline__ void kmean_unit(const P& p, int u, int tid, int lane, int wv, LAS unsigned char* lds) {
  const bf16_t* PROJ = (const bf16_t*)(p.ws + WS_PROJ);
  const int b = u >> 4, blk = u & 15;
  const bf16_t* src = PROJ + (size_t)(b * SEQ + blk * 256 + wv * 32) * LDP + C_MK + lane * 8;
  float s[8];
#pragma unroll
  for (int e = 0; e < 8; ++e) s[e] = 0.f;
#pragma unroll
  for (int i = 0; i < 32; ++i) { const u32x4 v = *(const u32x4*)(src + (size_t)i * LDP);
    s[0] += bflo(v.x); s[1] += bfhi(v.x); s[2] += bflo(v.y); s[3] += bfhi(v.y); s[4] += bflo(v.z); s[5] += bfhi(v.z); s[6] += bflo(v.w); s[7] += bfhi(v.w); }
  LAS float* red = (LAS float*)lds;
#pragma unroll
  for (int e = 0; e < 8; ++e) red[wv * 512 + lane * 8 + e] = s[e];
  __syncthreads();
  float t = 0.f;
#pragma unroll
  for (int w = 0; w < 8; ++w) t += red[w * 512 + tid];
  float* KM = (float*)(p.ws + WS_KMEAN);
  KM[((size_t)(b * 8 + (tid >> 6)) * 16 + blk) * 64 + (tid & 63)] = t * (1.f / 256.f);
  __syncthreads();
}

constexpr int S5_XP = 136;
struct S5C { float ar[2], ai[2], pwr[2][4], pwi[2][4]; bf16x8 Bf[4]; };
__device__ __forceinline__ void s5w_setup(const P& p, int layer, int g, int r, int hf, S5C& S) {
#pragma unroll
  for (int q = 0; q < 2; ++q) {
    const int gp = (layer * 32 + g) * 64 + q * 32 + r;
    const float lr = p.a_re[gp], li = p.a_im[gp], step = expf(p.log_dt[layer * 32 + g]);
    const float xr = lr * step, xi = li * step;
    const float er = expf(xr), em1 = expm1f(xr); float sn, cs; sincosf(xi, &sn, &cs);
    const float ar = er * cs, ai = er * sn;
    S.ar[q] = ar; S.ai[q] = ai;
    const float sh = sinf(0.5f * xi);
    const float nr = em1 * cs - 2.f * sh * sh, ni = ai;
    const float den = 1.f / (lr * lr + li * li);
    const float cr = (nr * lr + ni * li) * den, ci = (ni * lr - nr * li) * den;
    const float* br = p.b_re + (size_t)gp * 16 + 8 * hf; const float* bi = p.b_im + (size_t)gp * 16 + 8 * hf;
    const f32x4 r0 = *(const f32x4*)br, r1 = *(const f32x4*)(br + 4), i0 = *(const f32x4*)bi, i1 = *(const f32x4*)(bi + 4);
    union { bf16x8 v; unsigned w[4]; } fr, fi;
    fr.w[0] = pk2(cr * r0[0] - ci * i0[0], cr * r0[1] - ci * i0[1]); fr.w[1] = pk2(cr * r0[2] - ci * i0[2], cr * r0[3] - ci * i0[3]);
    fr.w[2] = pk2(cr * r1[0] - ci * i1[0], cr * r1[1] - ci * i1[1]); fr.w[3] = pk2(cr * r1[2] - ci * i1[2], cr * r1[3] - ci * i1[3]);
    fi.w[0] = pk2(cr * i0[0] + ci * r0[0], cr * i0[1] + ci * r0[1]); fi.w[1] = pk2(cr * i0[2] + ci * r0[2], cr * i0[3] + ci * r0[3]);
    fi.w[2] = pk2(cr * i1[0] + ci * r1[0], cr * i1[1] + ci * r1[1]); fi.w[3] = pk2(cr * i1[2] + ci * r1[2], cr * i1[3] + ci * r1[3]);
    S.Bf[2 * q] = fr.v; S.Bf[2 * q + 1] = fi.v;
    float pr = ar, pi = ai;
#pragma unroll
    for (int i = 0; i < 4; ++i) { S.pwr[q][i] = pr; S.pwi[q][i] = pi; const float n0 = pr * ar - pi * ai, n1 = pr * ai + pi * ar; pr = n0; pi = n1; }
  }
}
template <bool APPLY>
__device__ __forceinline__ void s5w_scan_tile(const S5C& S, const bf16x8 uf, f32x16 (&acc)[4], float (&cin)[2][2], int hf) {
#pragma unroll
  for (int kt = 0; kt < 4; ++kt) {
#pragma unroll
    for (int i = 0; i < 16; ++i) acc[kt][i] = 0.f;
    acc[kt] = MFMA32(uf, S.Bf[kt], acc[kt]);
  }
  float cgr[2][4], cgi[2][4];
#pragma unroll
  for (int q = 0; q < 2; ++q) {
    const float ar = S.ar[q], ai = S.ai[q];
#pragma unroll
    for (int G = 0; G < 4; ++G)
#pragma unroll
      for (int i = 1; i < 4; ++i) { const int k = 4 * G + i;
        const float xr = acc[2 * q][k - 1], xi = acc[2 * q + 1][k - 1];
        acc[2 * q][k] += ar * xr - ai * xi; acc[2 * q + 1][k] += ar * xi + ai * xr; }
  }
#pragma unroll
  for (int s = 0; s < 8; ++s) {
    const int G = s >> 1; const bool act = (hf == (s & 1));
#pragma unroll
    for (int q = 0; q < 2; ++q) {
      const float er = acc[2 * q][4 * G + 3] + S.pwr[q][3] * cin[q][0] - S.pwi[q][3] * cin[q][1];
      const float ei = acc[2 * q + 1][4 * G + 3] + S.pwr[q][3] * cin[q][1] + S.pwi[q][3] * cin[q][0];
      const float rr = __shfl_xor(er, 32), ri = __shfl_xor(ei, 32);
      if (s & 1) { if (hf) { cgr[q][G] = cin[q][0]; cgi[q][G] = cin[q][1]; } }
      else       { if (!hf) { cgr[q][G] = cin[q][0]; cgi[q][G] = cin[q][1]; } }
      cin[q][0] = act ? cin[q][0] : rr; cin[q][1] = act ? cin[q][1] : ri;
    }
  }
  if (APPLY) {
#pragma unroll
    for (int q = 0; q < 2; ++q)
#pragma unroll
      for (int G = 0; G < 4; ++G)
#pragma unroll
        for (int i = 0; i < 4; ++i) { const int k = 4 * G + i;
          acc[2 * q][k] += S.pwr[q][i] * cgr[q][G] - S.pwi[q][i] * cgi[q][G];
          acc[2 * q + 1][k] += S.pwr[q][i] * cgi[q][G] + S.pwi[q][i] * cgr[q][G]; }
  }
}
constexpr int S5_NCH = SEQ / 256;
__device__ __forceinline__ void s5_m1_task(const P& p, int layer, int task, int lane) {
  const bf16_t* PROJ = (const bf16_t*)(p.ws + WS_PROJ);
  const int g = task & 31, c = (task >> 5) & 15, b = task >> 9, r = lane & 31, hf = lane >> 5;
  S5C S; s5w_setup(p, layer, g, r, hf, S);
  float cin[2][2] = {{0.f, 0.f}, {0.f, 0.f}};
  const bf16_t* up = PROJ + (size_t)(b * SEQ + c * 256 + r) * LDP + C_SU + g * 16;
  f32x16 acc[4];
  bf16x8 ufc = *(const bf16x8*)(up + 8 * hf);
#pragma unroll 1
  for (int tt = 0; tt < 8; ++tt) {
    const bf16x8 ufn = *(const bf16x8*)(up + (size_t)(tt < 7 ? tt + 1 : tt) * 32 * LDP + 8 * hf);
    s5w_scan_tile<false>(S, ufc, acc, cin, hf);
    ufc = ufn;
  }
  if (hf == 0) {
    float* E = (float*)(p.ws + WS_S5E) + ((size_t)((b * 32 + g) * 16 + c) * 64 + r) * 2;
    *(float2*)E = make_float2(cin[0][0], cin[0][1]);
    *(float2*)(E + 64) = make_float2(cin[1][0], cin[1][1]);
  }
}
__device__ __forceinline__ void s5_m2_task(const P& p, int layer, int task_s, int task, int lane, LAS bf16_t* Xl) {
  const bf16_t* PROJ = (const bf16_t*)(p.ws + WS_PROJ); bf16_t* S5Y = (bf16_t*)(p.ws + WS_S5Y);
  const int g = task & 31, c = (task >> 5) & 15, b = task >> 9, r = lane & 31, hf = lane >> 5; const int c_s = (task_s >> 5) & 15;
  S5C S; s5w_setup(p, layer, g, r, hf, S);
  LAS bf16_t* Afl = Xl + 32 * S5_XP;
#pragma unroll
  for (int ks = 0; ks < 8; ++ks) {
    const int k0 = 16 * ks + 8 * hf, kt = k0 >> 5, rr = k0 & 31, p0 = (kt >> 1) * 32 + rr;
    if (r < 16) {
      const float* src = ((kt & 1) ? p.c_im : p.c_re) + ((size_t)(layer * 32 + g) * 16 + r) * 64 + p0;
      const f32x4 v0 = *(const f32x4*)src, v1 = *(const f32x4*)(src + 4); const float sg = (kt & 1) ? -1.f : 1.f;
      u32x4 f; f.x = pk2(sg * v0[0], sg * v0[1]); f.y = pk2(sg * v0[2], sg * v0[3]); f.z = pk2(sg * v1[0], sg * v1[1]); f.w = pk2(sg * v1[2], sg * v1[3]);
      *(LAS u32x4*)(Afl + (ks * 32 + r * 2 + hf) * 8) = f;
    }
  }
  asm volatile("s_waitcnt lgkmcnt(0)" ::: "memory");
  const f32x4 dsk0 = *(const f32x4*)(p.s5_d + layer * 512 + g * 16 + 4 * hf), dsk1 = *(const f32x4*)(p.s5_d + layer * 512 + g * 16 + 8 + 4 * hf);
  float cin[2][2];
#pragma unroll
  for (int q = 0; q < 2; ++q) {
    float pr = S.pwr[q][3], pi = S.pwi[q][3];
#pragma unroll
    for (int i = 0; i < 6; ++i) { const float n0 = pr * pr - pi * pi, n1 = 2.f * pr * pi; pr = n0; pi = n1; }
    float sr = 0.f, si = 0.f;
    const float* E = (const float*)(p.ws + WS_S5E) + ((size_t)((b * 32 + g) * 16) * 64 + q * 32 + r) * 2;
#pragma unroll 5
    for (int c2 = 0; c2 < c_s; ++c2) { const float2 e = *(const float2*)(E + (size_t)c2 * 128);
      const float n0 = pr * sr - pi * si + e.x, n1 = pr * si + pi * sr + e.y; sr = n0; si = n1; }
    cin[q][0] = sr; cin[q][1] = si;
  }
  const bf16_t* up = PROJ + (size_t)(b * SEQ + c * 256 + r) * LDP + C_SU + g * 16;
  bf16_t* yp = S5Y + (size_t)(b * SEQ + c * 256 + r) * S5YP + g * 16;
  bf16_t* mixp = (bf16_t*)(p.ws + WS_MIX) + (size_t)(b * SEQ + c * 256 + r) * MIXW + 1536 + g * 16;
  f32x16 acc[4];
  bf16x8 ufc = *(const bf16x8*)(up + 8 * hf);
#pragma unroll 1
  for (int tt = 0; tt < 8; ++tt) {
    const bf16_t* ur = up + (size_t)tt * 32 * LDP;
    const bf16x8 ufn = *(const bf16x8*)(up + (size_t)(tt < 7 ? tt + 1 : tt) * 32 * LDP + 8 * hf);
    s5w_scan_tile<true>(S, ufc, acc, cin, hf);
    ufc = ufn;
#pragma unroll
    for (int kt = 0; kt < 4; ++kt)
#pragma unroll
      for (int i = 0; i < 16; ++i) Xl[crow(i, hf) * S5_XP + 32 * kt + r] = f2bf(acc[kt][i]);
    asm volatile("s_waitcnt lgkmcnt(0)" ::: "memory");
    f32x16 y;
#pragma unroll
    for (int i = 0; i < 16; ++i) y[i] = 0.f;
#pragma unroll
    for (int ks = 0; ks < 8; ++ks) { const bf16x8 xf = *(const LAS bf16x8*)(Xl + r * S5_XP + 16 * ks + 8 * hf); const bf16x8 af = *(const LAS bf16x8*)(Afl + (ks * 32 + (r & 15) * 2 + hf) * 8); y = MFMA32(af, xf, y); }
    asm volatile("s_waitcnt lgkmcnt(0)" ::: "memory");
    const u32x2 u0 = *(const u32x2*)(ur + 4 * hf), u1 = *(const u32x2*)(ur + 8 + 4 * hf);
    u32x2 w0, w1;
    w0.x = pk2(gelu_tanh_f(y[0] + dsk0[0] * bflo(u0.x)), gelu_tanh_f(y[1] + dsk0[1] * bfhi(u0.x)));
    w0.y = pk2(gelu_tanh_f(y[2] + dsk0[2] * bflo(u0.y)), gelu_tanh_f(y[3] + dsk0[3] * bfhi(u0.y)));
    w1.x = pk2(gelu_tanh_f(y[4] + dsk1[0] * bflo(u1.x)), gelu_tanh_f(y[5] + dsk1[1] * bfhi(u1.x)));
    w1.y = pk2(gelu_tanh_f(y[6] + dsk1[2] * bflo(u1.y)), gelu_tanh_f(y[7] + dsk1[3] * bfhi(u1.y)));
    bf16_t* yr = yp + (size_t)tt * 32 * S5YP;
    *(u32x2*)(yr + 4 * hf) = w0; *(u32x2*)(yr + 8 + 4 * hf) = w1;
    { const u32x2 g0 = *(const u32x2*)(ur + (C_S5G - C_SU) + 4 * hf), g1 = *(const u32x2*)(ur + (C_S5G - C_SU) + 8 + 4 * hf);
      u32x2 m0, m1;
      m0.x = pk2(bflo(w0.x) * silu_f(bflo(g0.x)), bfhi(w0.x) * silu_f(bfhi(g0.x))); m0.y = pk2(bflo(w0.y) * silu_f(bflo(g0.y)), bfhi(w0.y) * silu_f(bfhi(g0.y)));
      m1.x = pk2(bflo(w1.x) * silu_f(bflo(g1.x)), bfhi(w1.x) * silu_f(bfhi(g1.x))); m1.y = pk2(bflo(w1.y) * silu_f(bflo(g1.y)), bfhi(w1.y) * silu_f(bfhi(g1.y)));
      bf16_t* mr = mixp + (size_t)tt * 32 * MIXW;
      *(u32x2*)(mr + 4 * hf) = m0; *(u32x2*)(mr + 8 + 4 * hf) = m1; }
  }
}

struct AttnAcc { f32x16 o0, o1; float m, l; };
template <int MASK>
__device__ __forceinline__ void attn_tile(AttnAcc& a, const bf16x8 (&qf)[4], const bf16_t* krow, const bf16_t* vt, int r, int hf, bool dead_col) {
  f32x16 s;
#pragma unroll
  for (int i = 0; i < 16; ++i) s[i] = 0.f;
#pragma unroll
  for (int ks = 0; ks < 4; ++ks) { const bf16x8 kf = *(const bf16x8*)(krow + 16 * ks); s = MFMA32(kf, qf[ks], s); }
  float mloc = -INFINITY;
#pragma unroll
  for (int i = 0; i < 16; ++i) {
    const int row = crow(i, hf);
    bool dead = dead_col;
    if (MASK == 1) dead = dead || (row > r);
    if (MASK == 2) dead = dead || (row <= r);
    s[i] = dead ? -INFINITY : s[i];
    mloc = fmaxf(mloc, s[i]);
  }
  mloc = fmaxf(mloc, __shfl_xor(mloc, 32));
  const float mnew = fmaxf(a.m, mloc);
  const float alpha = fexp2(a.m - mnew);
  float ls = 0.f;
#pragma unroll
  for (int i = 0; i < 16; ++i) { s[i] = fexp2(s[i] - mnew); ls += s[i]; }
  a.l = a.l * alpha + ls; a.m = mnew;
#pragma unroll
  for (int i = 0; i < 16; ++i) { a.o0[i] *= alpha; a.o1[i] *= alpha; }
  union { bf16x8 v; unsigned w[4]; } p0, p1;
#pragma unroll
  for (int i = 0; i < 4; ++i) { p0.w[i] = pk2(s[2 * i], s[2 * i + 1]); p1.w[i] = pk2(s[8 + 2 * i], s[8 + 2 * i + 1]); }
#pragma unroll
  for (int mb = 0; mb < 2; ++mb) {
    const bf16_t* vp = vt + (size_t)mb * 32 * TP;
    union { bf16x8 v; bf16x4 h[2]; } va, vb;
    va.h[0] = *(const bf16x4*)(vp); va.h[1] = *(const bf16x4*)(vp + 8);
    vb.h[0] = *(const bf16x4*)(vp + 16); vb.h[1] = *(const bf16x4*)(vp + 24);
    if (mb == 0) { a.o0 = MFMA32(va.v, p0.v, a.o0); a.o0 = MFMA32(vb.v, p1.v, a.o0); }
    else { a.o1 = MFMA32(va.v, p0.v, a.o1); a.o1 = MFMA32(vb.v, p1.v, a.o1); }
  }
}
__device__ __forceinline__ void attn_store(const AttnAcc& a, float ltot, const bf16_t* gaterow, bf16_t* outrow, int hf) {
  const float inv = 1.f / ltot;
#pragma unroll
  for (int mb = 0; mb < 2; ++mb)
#pragma unroll
    for (int q4 = 0; q4 < 4; ++q4) {
      const int d0 = 8 * q4 + 4 * hf + 32 * mb;
      const u32x2 gv = *(const u32x2*)(gaterow + d0);
      float o[4];
#pragma unroll
      for (int i = 0; i < 4; ++i) o[i] = (mb == 0 ? a.o0[4 * q4 + i] : a.o1[4 * q4 + i]) * inv;
      o[0] *= silu_f(bflo(gv.x)); o[1] *= silu_f(bfhi(gv.x)); o[2] *= silu_f(bflo(gv.y)); o[3] *= silu_f(bfhi(gv.y));
      u32x2 w; w.x = pk2(o[0], o[1]); w.y = pk2(o[2], o[3]);
      *(u32x2*)(outrow + d0) = w;
    }
}

constexpr int MB_KP = 72, MB_VP = 260, MB_KBYTES = 256 * MB_KP * 2, MB_VBYTES = 64 * MB_VP * 2, MB_BUF = MB_KBYTES + MB_VBYTES;
struct MobaStage { u32x4 k[4], v[4]; };
__device__ __forceinline__ void moba_stage_load(MobaStage& st, const bf16_t* kg, const bf16_t* vg, int tid) {
#pragma unroll
  for (int i = 0; i < 4; ++i) { const int idx = tid + 512 * i;
    st.k[i] = *(const u32x4*)(kg + (size_t)(idx >> 3) * LDP + (idx & 7) * 8);
    st.v[i] = *(const u32x4*)(vg + (size_t)(idx >> 5) * TP + (idx & 31) * 8); }
}
__device__ __forceinline__ void moba_stage_store(const MobaStage& st, LAS unsigned char* buf, int tid) {
#pragma unroll
  for (int i = 0; i < 4; ++i) { const int idx = tid + 512 * i;
    *(LAS u32x4*)(buf + ((idx >> 3) * MB_KP + (idx & 7) * 8) * 2) = st.k[i];
    LAS unsigned char* vp = buf + MB_KBYTES + ((idx >> 5) * MB_VP + (idx & 31) * 8) * 2;
    *(LAS u32x2*)vp = (u32x2){st.v[i].x, st.v[i].y}; *(LAS u32x2*)(vp + 8) = (u32x2){st.v[i].z, st.v[i].w}; }
}
template <int MASK>
__device__ __forceinline__ void attn_tile_lds(AttnAcc& a, const bf16x8 (&qf)[4], const LAS unsigned char* buf, int tile, int r, int hf, bool dead_col) {
  f32x16 s;
#pragma unroll
  for (int i = 0; i < 16; ++i) s[i] = 0.f;
  const LAS bf16_t* kp = (const LAS bf16_t*)buf + (tile * 32 + r) * MB_KP + 8 * hf;
#pragma unroll
  for (int ks = 0; ks < 4; ++ks) { const bf16x8 kf = *(const LAS bf16x8*)(kp + 16 * ks); s = MFMA32(kf, qf[ks], s); }
  float mloc = -INFINITY;
#pragma unroll
  for (int i = 0; i < 16; ++i) {
    if (MASK == 1) { const int row = crow(i, hf); s[i] = (row > r) ? -INFINITY : s[i]; }
    if (MASK == 2) { const int row = crow(i, hf); s[i] = (row <= r) ? -INFINITY : s[i]; }
    mloc = fmaxf(mloc, s[i]);
  }
  mloc = dead_col ? -INFINITY : mloc;
  mloc = fmaxf(mloc, __shfl_xor(mloc, 32));
  const float mnew = fmaxf(a.m, mloc);
  const float alpha = fexp2(a.m - mnew);
  const float msub = dead_col ? INFINITY : mnew;
  float ls = 0.f;
#pragma unroll
  for (int i = 0; i < 16; ++i) { s[i] = fexp2(s[i] - msub); ls += s[i]; }
  a.l = a.l * alpha + ls; a.m = mnew;
  if (__ballot(alpha != 1.f) != 0ull) {
#pragma unroll
    for (int i = 0; i < 16; ++i) { a.o0[i] *= alpha; a.o1[i] *= alpha; }
  }
  union { bf16x8 v; unsigned w[4]; } p0, p1;
#pragma unroll
  for (int i = 0; i < 4; ++i) { p0.w[i] = pk2(s[2 * i], s[2 * i + 1]); p1.w[i] = pk2(s[8 + 2 * i], s[8 + 2 * i + 1]); }
  const LAS bf16_t* vb = (const LAS bf16_t*)(buf + MB_KBYTES) + r * MB_VP + tile * 32 + 4 * hf;
#pragma unroll
  for (int mb = 0; mb < 2; ++mb) {
    const LAS bf16_t* vp = vb + mb * 32 * MB_VP;
    union { bf16x8 v; bf16x4 h[2]; } va, vbb;
    va.h[0] = *(const LAS bf16x4*)(vp); va.h[1] = *(const LAS bf16x4*)(vp + 8);
    vbb.h[0] = *(const LAS bf16x4*)(vp + 16); vbb.h[1] = *(const LAS bf16x4*)(vp + 24);
    if (mb == 0) { a.o0 = MFMA32(va.v, p0.v, a.o0); a.o0 = MFMA32(vbb.v, p1.v, a.o0); }
    else { a.o1 = MFMA32(va.v, p0.v, a.o1); a.o1 = MFMA32(vbb.v, p1.v, a.o1); }
  }
}
__device__ __forceinline__ void attn_tile_lds_frozen(AttnAcc& a, const bf16x8 (&qf)[4], const LAS unsigned char* buf, int tile, int r, int hf, float msub, float& smax) {
  f32x16 s;
#pragma unroll
  for (int i = 0; i < 16; ++i) s[i] = 0.f;
  const LAS bf16_t* kp = (const LAS bf16_t*)buf + (tile * 32 + r) * MB_KP + 8 * hf;
#pragma unroll
  for (int ks = 0; ks < 4; ++ks) { const bf16x8 kf = *(const LAS bf16x8*)(kp + 16 * ks); s = MFMA32(kf, qf[ks], s); }
  float ls = 0.f;
#pragma unroll
  for (int i = 0; i < 16; ++i) { smax = fmaxf(smax, s[i]); s[i] = fexp2(s[i] - msub); ls += s[i]; }
  a.l += ls;
  union { bf16x8 v; unsigned w[4]; } p0, p1;
#pragma unroll
  for (int i = 0; i < 4; ++i) { p0.w[i] = pk2(s[2 * i], s[2 * i + 1]); p1.w[i] = pk2(s[8 + 2 * i], s[8 + 2 * i + 1]); }
  const LAS bf16_t* vb = (const LAS bf16_t*)(buf + MB_KBYTES) + r * MB_VP + tile * 32 + 4 * hf;
#pragma unroll
  for (int mb = 0; mb < 2; ++mb) {
    const LAS bf16_t* vp = vb + mb * 32 * MB_VP;
    union { bf16x8 v; bf16x4 h[2]; } va, vbb;
    va.h[0] = *(const LAS bf16x4*)(vp); va.h[1] = *(const LAS bf16x4*)(vp + 8);
    vbb.h[0] = *(const LAS bf16x4*)(vp + 16); vbb.h[1] = *(const LAS bf16x4*)(vp + 24);
    if (mb == 0) { a.o0 = MFMA32(va.v, p0.v, a.o0); a.o0 = MFMA32(vbb.v, p1.v, a.o0); }
    else { a.o1 = MFMA32(va.v, p0.v, a.o1); a.o1 = MFMA32(vbb.v, p1.v, a.o1); }
  }
}
__device__ __forceinline__ void moba_subunit(const P& p, int b, int h, int qb, int wq, int wqv, int lane, int tid, LAS unsigned char* lds) {
  const bf16_t* PROJ = (const bf16_t*)(p.ws + WS_PROJ); bf16_t* MIX = (bf16_t*)(p.ws + WS_MIX);
  const bf16_t* kg0 = PROJ + (size_t)b * SEQ * LDP + C_MK + h * 64;
  const bf16_t* vg0 = (const bf16_t*)(p.ws + WS_MVT) + (size_t)(b * 8 + h) * 64 * TP;
  const int r = lane & 31, hf = lane >> 5, q0 = qb * 256 + wqv * 32;
  const size_t rowq = (size_t)b * SEQ + q0 + r;
  MobaStage st;
  moba_stage_load(st, kg0 + (size_t)qb * 256 * LDP, vg0 + qb * 256, tid);
  bf16x8 qf[4];
#pragma unroll
  for (int ks = 0; ks < 4; ++ks) qf[ks] = *(const bf16x8*)(PROJ + rowq * LDP + C_MQ + h * 64 + 16 * ks + 8 * hf);
  unsigned sel = 0;
  if (qb > 0) {
    float v1 = -INFINITY, v2 = -INFINITY, v3 = -INFINITY; int i1 = 31, i2 = 31, i3 = 31;
    const float* km = (const float*)(p.ws + WS_KMEAN) + (size_t)(b * 8 + h) * 16 * 64 + 8 * hf;
#pragma unroll
    for (int j = 0; j < 15; ++j) {
      if (j < qb) {
        float g = 0.f;
#pragma unroll
        for (int ks = 0; ks < 4; ++ks) {
          const f32x4 k0 = *(const f32x4*)(km + j * 64 + 16 * ks), k1 = *(const f32x4*)(km + j * 64 + 16 * ks + 4);
          g += bf2f((unsigned short)qf[ks][0]) * k0[0] + bf2f((unsigned short)qf[ks][1]) * k0[1] + bf2f((unsigned short)qf[ks][2]) * k0[2] + bf2f((unsigned short)qf[ks][3]) * k0[3];
          g += bf2f((unsigned short)qf[ks][4]) * k1[0] + bf2f((unsigned short)qf[ks][5]) * k1[1] + bf2f((unsigned short)qf[ks][6]) * k1[2] + bf2f((unsigned short)qf[ks][7]) * k1[3];
        }
        g += __shfl_xor(g, 32);
        if (g > v1) { v3 = v2; i3 = i2; v2 = v1; i2 = i1; v1 = g; i1 = j; }
        else if (g > v2) { v3 = v2; i3 = i2; v2 = g; i2 = j; }
        else if (g > v3) { v3 = g; i3 = j; }
      }
    }
    sel = ((1u << i1) | (1u << i2) | (1u << i3)) & ((1u << qb) - 1u);
  }
  AttnAcc a;
#pragma unroll
  for (int i = 0; i < 16; ++i) { a.o0[i] = 0.f; a.o1[i] = 0.f; }
  a.m = -INFINITY; a.l = 0.f;
  moba_stage_store(st, lds, tid);
  __syncthreads();
  const int nblk = qb + 1;
#pragma unroll 1
  for (int it = 0; it < nblk; ++it) {
    const bool more = it + 1 < nblk;
    if (more) moba_stage_load(st, kg0 + (size_t)it * 256 * LDP, vg0 + it * 256, tid);
    const LAS unsigned char* buf = lds + (it & 1) * MB_BUF;
    if (it == 0) {
      attn_tile_lds<1>(a, qf, buf, wqv, r, hf, false);
      for (int i = 0; i < wq; ++i) attn_tile_lds<0>(a, qf, buf, i, r, hf, false);
    } else {
      const bool on = (sel >> (it - 1)) & 1u;
      if (__ballot(on) != 0ull) {
        const float msub = on ? a.m : INFINITY;
        float smax = -INFINITY;
#pragma unroll 2
        for (int t = 0; t < 8; ++t) attn_tile_lds_frozen(a, qf, buf, t, r, hf, msub, smax);
        smax = on ? smax : -INFINITY;
        smax = fmaxf(smax, __shfl_xor(smax, 32));
        const float mnew = fmaxf(a.m, smax), alpha = fexp2(a.m - mnew);
        a.m = mnew;
        if (__ballot(alpha != 1.f) != 0ull) {
          a.l *= alpha;
#pragma unroll
          for (int i = 0; i < 16; ++i) { a.o0[i] *= alpha; a.o1[i] *= alpha; }
        }
      }
    }
    if (more) moba_stage_store(st, lds + ((it + 1) & 1) * MB_BUF, tid);
    __syncthreads();
  }
  const float ltot = a.l + __shfl_xor(a.l, 32);
  attn_store(a, ltot, PROJ + rowq * LDP + C_MG + h * 64, MIX + rowq * MIXW + h * 64, hf);
}

__device__ __forceinline__ void swa_unit(const P& p, int layer, int b, int kvh, int Q, int wq, int wqv, int lane, int tid, LAS unsigned char* lds) {
  const bf16_t* PROJ = (const bf16_t*)(p.ws + WS_PROJ); bf16_t* MIX = (bf16_t*)(p.ws + WS_MIX);
  const bf16_t* kg0 = PROJ + (size_t)b * SEQ * LDP + C_SK + kvh * 64;
  const bf16_t* vg0 = (const bf16_t*)(p.ws + WS_SVT) + (size_t)(b * 2 + kvh) * 64 * TP;
  const int r = lane & 31, hf = lane >> 5, q0 = Q * 256 + wqv * 32;
  const size_t rowq = (size_t)b * SEQ + q0 + r;
  { MobaStage st;
    if (Q > 0) { moba_stage_load(st, kg0 + (size_t)(Q - 1) * 256 * LDP, vg0 + (Q - 1) * 256, tid); moba_stage_store(st, lds, tid); }
    moba_stage_load(st, kg0 + (size_t)Q * 256 * LDP, vg0 + Q * 256, tid); moba_stage_store(st, lds + MB_BUF, tid); }
  __syncthreads();
  const LAS unsigned char* bprev = lds; const LAS unsigned char* bown = lds + MB_BUF;
#pragma unroll 1
  for (int hh = 0; hh < 4; ++hh) {
    const int hq = kvh * 4 + hh;
    bf16x8 qf[4];
#pragma unroll
    for (int ks = 0; ks < 4; ++ks) qf[ks] = *(const bf16x8*)(PROJ + rowq * LDP + C_SQ + hq * 64 + 16 * ks + 8 * hf);
    AttnAcc a;
#pragma unroll
    for (int i = 0; i < 16; ++i) { a.o0[i] = 0.f; a.o1[i] = 0.f; }
    a.m = -INFINITY; a.l = 0.f;
    attn_tile_lds<1>(a, qf, bown, wqv, r, hf, false);
#pragma unroll
    for (int d = 1; d <= 3; ++d) {
      if (wq - d >= 0) attn_tile_lds<0>(a, qf, bown, wqv - d, r, hf, false);
      else if (Q > 0) attn_tile_lds<0>(a, qf, bprev, 8 + wqv - d, r, hf, false);
    }
    if (wq - 4 >= 0) attn_tile_lds<2>(a, qf, bown, wqv - 4, r, hf, false);
    else if (Q > 0) attn_tile_lds<2>(a, qf, bprev, 4 + wqv, r, hf, false);
    float ltot = a.l + __shfl_xor(a.l, 32);
    ltot += fexp2(p.sinks[layer * 8 + hq] * LOG2E - a.m);
    attn_store(a, ltot, PROJ + rowq * LDP + C_SG + hq * 64, MIX + rowq * MIXW + 1024 + hq * 64, hf);
  }
  __syncthreads();
}

__device__ __forceinline__ void swa_task(const P& p, int layer, int b, int hq, int qt_s, int qt, int lane) {
  const bf16_t* PROJ = (const bf16_t*)(p.ws + WS_PROJ); bf16_t* MIX = (bf16_t*)(p.ws + WS_MIX);
  const int kvh = hq >> 2;
  const bf16_t* VT = (const bf16_t*)(p.ws + WS_SVT) + (size_t)(b * 2 + kvh) * 64 * TP;
  const int r = lane & 31, hf = lane >> 5, q0 = qt * 32;
  const size_t rowq = (size_t)b * SEQ + q0 + r;
  const int nt = qt_s < 4 ? qt_s : 4;
  bf16x8 qa[4], qb[4];
#pragma unroll
  for (int ks = 0; ks < 4; ++ks) { qa[ks] = *(const bf16x8*)(PROJ + rowq * LDP + C_SQ + hq * 64 + 16 * ks + 8 * hf); qb[ks] = *(const bf16x8*)(PROJ + rowq * LDP + C_SQ + (hq + 1) * 64 + 16 * ks + 8 * hf); }
  AttnAcc a0, a1;
#pragma unroll
  for (int i = 0; i < 16; ++i) { a0.o0[i] = 0.f; a0.o1[i] = 0.f; a1.o0[i] = 0.f; a1.o1[i] = 0.f; }
  a0.m = -INFINITY; a0.l = 0.f; a1.m = -INFINITY; a1.l = 0.f;
  const bf16_t* kbase = PROJ + ((size_t)b * SEQ + r) * LDP + C_SK + kvh * 64 + 8 * hf;
  const bf16_t* vbase = VT + (size_t)r * TP + 4 * hf;
  attn_tile<1>(a0, qa, kbase + (size_t)q0 * LDP, vbase + q0, r, hf, false); attn_tile<1>(a1, qb, kbase + (size_t)q0 * LDP, vbase + q0, r, hf, false);
  for (int d = 1; d <= 3; ++d) if (nt >= d) { attn_tile<0>(a0, qa, kbase + (size_t)(q0 - 32 * d) * LDP, vbase + q0 - 32 * d, r, hf, false); attn_tile<0>(a1, qb, kbase + (size_t)(q0 - 32 * d) * LDP, vbase + q0 - 32 * d, r, hf, false); }
  if (nt >= 4) { attn_tile<2>(a0, qa, kbase + (size_t)(q0 - 128) * LDP, vbase + q0 - 128, r, hf, false); attn_tile<2>(a1, qb, kbase + (size_t)(q0 - 128) * LDP, vbase + q0 - 128, r, hf, false); }
  float lt0 = a0.l + __shfl_xor(a0.l, 32), lt1 = a1.l + __shfl_xor(a1.l, 32);
  lt0 += fexp2(p.sinks[layer * 8 + hq] * LOG2E - a0.m); lt1 += fexp2(p.sinks[layer * 8 + hq + 1] * LOG2E - a1.m);
  attn_store(a0, lt0, PROJ + rowq * LDP + C_SG + hq * 64, MIX + rowq * MIXW + 1024 + hq * 64, hf);
  attn_store(a1, lt1, PROJ + rowq * LDP + C_SG + (hq + 1) * 64, MIX + rowq * MIXW + 1024 + (hq + 1) * 64, hf);
}

__device__ __forceinline__ void ssd_state_unit(const P& p, int u, int lane, int wave, int tid, LAS unsigned char* lds) {
  const int h = u & 7, b = u >> 3, g = h >> 2;
  const int r = lane & 31, hf = lane >> 5, nt = wave & 3, pt = wave >> 2;
  LAS float* dl = (LAS float*)lds; LAS float* de = dl + 15 * 256;
  const float* acb = (const float*)(p.ws + WS_ACUM) + (size_t)(b * 8 + h) * SEQ;
  __syncthreads();
  for (int i = tid; i < 15 * 256; i += 512) dl[i] = fexp(acb[(i & ~255) + 255] - acb[i]);
  if (tid < 15) de[tid] = fexp(acb[tid * 256 + 255]);
  __syncthreads();
  f32x16 st;
#pragma unroll
  for (int i = 0; i < 16; ++i) st[i] = 0.f;
#pragma unroll 1
  for (int c = 0; c < 15; ++c) {
    const bf16_t* xrow = (const bf16_t*)(p.ws + WS_XDT) + ((size_t)(b * 8 + h) * 64 + pt * 32 + r) * TP + c * 256 + 8 * hf;
    const bf16_t* brow = (const bf16_t*)(p.ws + WS_BT) + ((size_t)(b * 2 + g) * 128 + nt * 32 + r) * TP + c * 256 + 8 * hf;
    const LAS float* dc = dl + c * 256 + 8 * hf;
    f32x16 acc;
#pragma unroll
    for (int i = 0; i < 16; ++i) acc[i] = 0.f;
#pragma unroll
    for (int ks = 0; ks < 16; ++ks) {
      const u32x4 xa = *(const u32x4*)(xrow + 16 * ks);
      const f32x4 d0 = *(const LAS f32x4*)(dc + 16 * ks), d1 = *(const LAS f32x4*)(dc + 16 * ks + 4);
      union { bf16x8 v; unsigned w[4]; } xs;
      xs.w[0] = pk2(bflo(xa.x) * d0[0], bfhi(xa.x) * d0[1]);
      xs.w[1] = pk2(bflo(xa.y) * d0[2], bfhi(xa.y) * d0[3]);
      xs.w[2] = pk2(bflo(xa.z) * d1[0], bfhi(xa.z) * d1[1]);
      xs.w[3] = pk2(bflo(xa.w) * d1[2], bfhi(xa.w) * d1[3]);
      const bf16x8 bb = *(const bf16x8*)(brow + 16 * ks);
      acc = MFMA32(xs.v, bb, acc);
    }
    const float dec = de[c];
    bf16_t* SP = (bf16_t*)(p.ws + WS_CS) + (size_t)((b * 16 + c + 1) * 8 + h) * 8192;
#pragma unroll
    for (int i = 0; i < 16; ++i) { st[i] = st[i] * dec + acc[i]; SP[(pt * 32 + crow(i, hf)) * 128 + nt * 32 + r] = f2bf(st[i]); }
  }
}

constexpr int SP_PITCH = 136;
__device__ __forceinline__ void ssd_out_unit(const P& p, int layer, int u, LAS unsigned char* lds, int tid, int lane, int wave, int wv) {
  const int half = u & 1, g = (u >> 1) & 1, c = (u >> 2) & 15, b = u >> 6;
  const bf16_t* PROJ = (const bf16_t*)(p.ws + WS_PROJ); const bf16_t* XC = (const bf16_t*)(p.ws + WS_XC); bf16_t* MIX = (bf16_t*)(p.ws + WS_MIX);
  const float* ACUM = (const float*)(p.ws + WS_ACUM);
  LAS float* ssx = (LAS float*)lds;
  const bf16_t* SPREV = (const bf16_t*)(p.ws + WS_CS);
  const int r = lane & 31, hf = lane >> 5, lt = (wave & 3) + 4 * half, hp = wv >> 2;
  const int l = ((wv & 3) + 4 * half) * 32 + r; const size_t rowl = (size_t)b * SEQ + c * 256 + l;
  bf16x8 Cf[8];
#pragma unroll
  for (int ks = 0; ks < 8; ++ks) Cf[ks] = *(const bf16x8*)(XC + rowl * 1024 + 768 + g * 128 + 16 * ks + 8 * hf);
  f32x16 o[2][2]; float acl[2];
#pragma unroll
  for (int e = 0; e < 2; ++e) {
    const int hh = 2 * hp + e, h = 4 * g + hh;
    acl[e] = ACUM[(size_t)(b * 8 + h) * SEQ + c * 256 + l];
    const float sc = fexp(acl[e]);
#pragma unroll
    for (int mb = 0; mb < 2; ++mb) {
      f32x16 t;
#pragma unroll
      for (int i = 0; i < 16; ++i) t[i] = 0.f;
      if (c > 0) {
        const bf16_t* sp = SPREV + (size_t)((b * 16 + c) * 8 + h) * 8192 + (mb * 32 + r) * 128 + 8 * hf;
#pragma unroll
        for (int ks = 0; ks < 8; ++ks) { const bf16x8 A = *(const bf16x8*)(sp + 16 * ks); t = MFMA32(A, Cf[ks], t); }
#pragma unroll
        for (int i = 0; i < 16; ++i) t[i] *= sc;
      }
      o[e][mb] = t;
    }
  }
#pragma unroll 2
  for (int st = 0; st <= lt; ++st) {
    f32x16 G;
#pragma unroll
    for (int i = 0; i < 16; ++i) G[i] = 0.f;
    const bf16_t* bp = XC + ((size_t)b * SEQ + c * 256 + st * 32 + r) * 1024 + 512 + g * 128 + 8 * hf;
#pragma unroll
    for (int ks = 0; ks < 8; ++ks) { const bf16x8 A = *(const bf16x8*)(bp + 16 * ks); G = MFMA32(A, Cf[ks], G); }
#pragma unroll
    for (int e = 0; e < 2; ++e) {
      const int h = 4 * g + 2 * hp + e;
      const float* as = ACUM + (size_t)(b * 8 + h) * SEQ + c * 256 + st * 32 + 4 * hf;
      float pv[16];
#pragma unroll
      for (int q4 = 0; q4 < 4; ++q4) { const f32x4 a4 = *(const f32x4*)(as + 8 * q4);
#pragma unroll
        for (int i = 0; i < 4; ++i) { const int reg = 4 * q4 + i; const float w = G[reg] * fexp(acl[e] - a4[i]);
          pv[reg] = (st < lt || crow(reg, hf) <= r) ? w : 0.f; } }
      union { bf16x8 v; unsigned w[4]; } p0, p1;
#pragma unroll
      for (int i = 0; i < 4; ++i) { p0.w[i] = pk2(pv[2 * i], pv[2 * i + 1]); p1.w[i] = pk2(pv[8 + 2 * i], pv[8 + 2 * i + 1]); }
      const bf16_t* xt = (const bf16_t*)(p.ws + WS_XDT) + ((size_t)(b * 8 + h) * 64 + r) * TP + c * 256 + st * 32 + 4 * hf;
#pragma unroll
      for (int mb = 0; mb < 2; ++mb) {
        const bf16_t* vp = xt + (size_t)mb * 32 * TP;
        union { bf16x8 v; bf16x4 hh[2]; } va, vb;
        va.hh[0] = *(const bf16x4*)(vp); va.hh[1] = *(const bf16x4*)(vp + 8);
        vb.hh[0] = *(const bf16x4*)(vp + 16); vb.hh[1] = *(const bf16x4*)(vp + 24);
        o[e][mb] = MFMA32(va.v, p0.v, o[e][mb]); o[e][mb] = MFMA32(vb.v, p1.v, o[e][mb]);
      }
    }
  }
  float ssq = 0.f;
#pragma unroll
  for (int e = 0; e < 2; ++e) {
    const int h = 4 * g + 2 * hp + e; const float Dh = p.ssd_d[layer * 8 + h];
#pragma unroll
    for (int mb = 0; mb < 2; ++mb)
#pragma unroll
      for (int q4 = 0; q4 < 4; ++q4) {
        const int p0 = 8 * q4 + 4 * hf + 32 * mb;
        const u32x2 xv = *(const u32x2*)(XC + rowl * 1024 + h * 64 + p0);
        const u32x2 zv = *(const u32x2*)(PROJ + rowl * LDP + C_Z + h * 64 + p0);
        float y0 = (o[e][mb][4 * q4 + 0] + Dh * bflo(xv.x)) * silu_f(bflo(zv.x));
        float y1 = (o[e][mb][4 * q4 + 1] + Dh * bfhi(xv.x)) * silu_f(bfhi(zv.x));
        float y2 = (o[e][mb][4 * q4 + 2] + Dh * bflo(xv.y)) * silu_f(bflo(zv.y));
        float y3 = (o[e][mb][4 * q4 + 3] + Dh * bfhi(xv.y)) * silu_f(bfhi(zv.y));
        o[e][mb][4 * q4 + 0] = y0; o[e][mb][4 * q4 + 1] = y1; o[e][mb][4 * q4 + 2] = y2; o[e][mb][4 * q4 + 3] = y3;
        ssq += y0 * y0 + y1 * y1 + y2 * y2 + y3 * y3;
      }
  }
  ssq += __shfl_xor(ssq, 32);
  if (hf == 0) ssx[wv * 32 + r] = ssq;
  __syncthreads();
  const float tot = ssx[wv * 32 + r] + ssx[(wv ^ 4) * 32 + r];
  const float rstd = 1.f / sqrtf(tot * (1.f / 256.f) + NORM_EPS);
#pragma unroll
  for (int e = 0; e < 2; ++e) {
    const int h = 4 * g + 2 * hp + e;
#pragma unroll
    for (int mb = 0; mb < 2; ++mb)
#pragma unroll
      for (int q4 = 0; q4 < 4; ++q4) {
        const int p0 = 8 * q4 + 4 * hf + 32 * mb;
        const f32x4 nw = *(const f32x4*)(p.ssd_norm + layer * 512 + h * 64 + p0);
        u32x2 w; w.x = pk2(o[e][mb][4 * q4 + 0] * rstd * nw[0], o[e][mb][4 * q4 + 1] * rstd * nw[1]);
        w.y = pk2(o[e][mb][4 * q4 + 2] * rstd * nw[2], o[e][mb][4 * q4 + 3] * rstd * nw[3]);
        *(u32x2*)(MIX + rowl * MIXW + 512 + h * 64 + p0) = w;
      }
  }
  __syncthreads();
}

template <int NR, bool IN_BF, bool OUT_BF>
__device__ __forceinline__ void postnorm_rows(const bf16_t* Y, const void* xin_, void* xout_, const float* pg, const float* ng, bf16_t* H, int m0, int stride, int lane) {
  f32x4 v[NR][8], xx[NR][8]; float ss[NR];
#pragma unroll
  for (int i = 0; i < NR; ++i) { const size_t ro = (size_t)(m0 + i * stride) * DM + 4 * lane; ss[i] = 0.f;
#pragma unroll
    for (int j = 0; j < 8; ++j) { const u32x2 yv = *(const u32x2*)(Y + ro + 256 * j); v[i][j] = (f32x4){bflo(yv.x), bfhi(yv.x), bflo(yv.y), bfhi(yv.y)};
      if (IN_BF) { const u32x2 xv = *(const u32x2*)((const bf16_t*)xin_ + ro + 256 * j); xx[i][j] = (f32x4){bflo(xv.x), bfhi(xv.x), bflo(xv.y), bfhi(xv.y)}; }
      else xx[i][j] = *(const f32x4*)((const float*)xin_ + ro + 256 * j); } }
#pragma unroll
  for (int i = 0; i < NR; ++i) {
#pragma unroll
    for (int j = 0; j < 8; ++j) ss[i] += v[i][j].x * v[i][j].x + v[i][j].y * v[i][j].y + v[i][j].z * v[i][j].z + v[i][j].w * v[i][j].w;
    ss[i] = wave_sum(ss[i]); }
#pragma unroll
  for (int i = 0; i < NR; ++i) {
    const size_t ro = (size_t)(m0 + i * stride) * DM + 4 * lane;
    const float rstd = 1.f / sqrtf(ss[i] * (1.f / DM) + NORM_EPS);
    float s2 = 0.f;
#pragma unroll
    for (int j = 0; j < 8; ++j) { const f32x4 gg = *(const f32x4*)(pg + 4 * lane + 256 * j);
      v[i][j] = xx[i][j] + v[i][j] * rstd * gg;
      if (OUT_BF) { u32x2 o; o.x = pk2(v[i][j].x, v[i][j].y); o.y = pk2(v[i][j].z, v[i][j].w); *(u32x2*)((bf16_t*)xout_ + ro + 256 * j) = o; }
      else *(f32x4*)((float*)xout_ + ro + 256 * j) = v[i][j];
      s2 += v[i][j].x * v[i][j].x + v[i][j].y * v[i][j].y + v[i][j].z * v[i][j].z + v[i][j].w * v[i][j].w; }
    if (ng) {
      const float r2 = 1.f / sqrtf(wave_sum(s2) * (1.f / DM) + NORM_EPS);
#pragma unroll
      for (int j = 0; j < 8; ++j) { const f32x4 gg = *(const f32x4*)(ng + 4 * lane + 256 * j);
        u32x2 o; o.x = pk2(v[i][j].x * r2 * gg.x, v[i][j].y * r2 * gg.y); o.y = pk2(v[i][j].z * r2 * gg.z, v[i][j].w * r2 * gg.w);
        *(u32x2*)(H + ro + 256 * j) = o; }
    }
  }
}

#ifndef RU_MOBA
#define RU_MOBA 1
#endif
#ifndef RU_SWA
#define RU_SWA 1
#endif
#ifndef RU_ST
#define RU_ST 1
#endif
#ifndef RU_S5M2
#define RU_S5M2 1
#endif
#ifndef RU_SSDOUT
#define RU_SSDOUT 1
#endif
#ifndef RU_CONV
#define RU_CONV 1
#endif
#ifndef RU_S5M1
#define RU_S5M1 1
#endif
#ifndef RU_VT
#define RU_VT 1
#endif
namespace xb {
#define XB_TMO      128
#define XB_XCNT(j)  (256  + 64 * (j))
#define XB_XSUB(j)  (1280 + 64 * (j))
#define XB_XGEN(j)  (2304 + 64 * (j))
#define XB_TOP      3328
#define XB_TOPGEN   3392
#define XCD_BAR_WORDS 3456
#define XB_SPIN_CAP (1u << 18)

__device__ __forceinline__ unsigned xb_ld(unsigned* p)              { return __hip_atomic_load(p, __ATOMIC_RELAXED, __HIP_MEMORY_SCOPE_AGENT); }
__device__ __forceinline__ unsigned xb_add(unsigned* p, unsigned v) { return __hip_atomic_fetch_add(p, v, __ATOMIC_RELAXED, __HIP_MEMORY_SCOPE_AGENT); }
__device__ __forceinline__ unsigned xb_xcc_id() { return (unsigned)__builtin_amdgcn_s_getreg((3 << 11) | 20) & 0xFu; }
#define XB_SPIN(cond, bar) do { unsigned _sp = 0; while (cond) { __builtin_amdgcn_s_sleep(1); \
    if ((++_sp & 255u) == 0u) { if (xb_ld(&(bar)[XB_TMO])) break; if (_sp > XB_SPIN_CAP) { atomicAdd(&(bar)[XB_TMO], 1u); break; } } } } while (0)

struct XcdBarrier {
    unsigned* bar; unsigned x;
    volatile LAS unsigned* st;
};

__device__ __forceinline__ XcdBarrier xcd_barrier_post(unsigned* bar, volatile LAS unsigned* st) {
    XcdBarrier b; b.bar = bar; b.x = xb_xcc_id(); b.st = st;
    if (threadIdx.x == 0) (void)xb_add(&bar[XB_XCNT(b.x)], 1u);
    return b;
}
__device__ __forceinline__ void xcd_barrier_complete(unsigned* bar, unsigned x, unsigned& nloc, unsigned& nx) {
    const unsigned G = gridDim.x * gridDim.y * gridDim.z;
    unsigned sum, cnt, mine, sp = 0u;
    for (;;) {
        sum = 0u; cnt = 0u; mine = 0u;
#pragma unroll
        for (unsigned j = 0; j < 16; ++j) { const unsigned c = xb_ld(&bar[XB_XCNT(j)]); sum += c; cnt += (c > 0u) ? 1u : 0u; mine = (j == x) ? c : mine; }
        if (sum == G) break;
        __builtin_amdgcn_s_sleep(1);
        if ((++sp & 255u) == 0u) { if (xb_ld(&bar[XB_TMO])) break; if (sp > XB_SPIN_CAP) { atomicAdd(&bar[XB_TMO], 1u); break; } }
    }
    nloc = mine > 0u ? mine : 1u; nx = cnt > 0u ? cnt : 1u;
}

__device__ __forceinline__ void xcd_barrier(const XcdBarrier& b) {
    asm volatile("s_waitcnt vmcnt(0)" ::: "memory");
    __syncthreads();
    if (threadIdx.x == 0) {
        unsigned* bar = b.bar;
        __builtin_amdgcn_s_waitcnt(0);
        unsigned nloc = b.st[0], nx = b.st[1];
        if (nloc == 0u) { xcd_barrier_complete(bar, b.x, nloc, nx); b.st[0] = nloc; b.st[1] = nx; }
        const unsigned old = xb_add(&bar[XB_XSUB(b.x)], 1u);
        const unsigned gen = old / nloc;
        if (old + 1u == (gen + 1u) * nloc) {
            __builtin_amdgcn_fence(__ATOMIC_RELEASE, "agent");
            asm volatile("s_waitcnt vmcnt(0)" ::: "memory");
            const unsigned og = xb_add(&bar[XB_TOP], 1u);
            const unsigned tg = og / nx;
            if (og + 1u == (tg + 1u) * nx) xb_add(&bar[XB_TOPGEN], 1u);
            else XB_SPIN(xb_ld(&bar[XB_TOPGEN]) == tg, bar);
            __builtin_amdgcn_fence(__ATOMIC_ACQUIRE, "agent");
            xb_add(&bar[XB_XGEN(b.x)], 1u);
            asm volatile("s_waitcnt vmcnt(0)" ::: "memory");
        } else {
            XB_SPIN(xb_ld(&bar[XB_XGEN(b.x)]) == gen, bar);
            __builtin_amdgcn_fence(__ATOMIC_ACQUIRE, "agent");
            asm volatile("s_waitcnt vmcnt(0)" ::: "memory");
        }
    }
    __syncthreads();
}

}
__global__ void __launch_bounds__(512, 2) fwd_mega(P p_unused) {
  const unsigned long long kp = (unsigned long long)__builtin_amdgcn_kernarg_segment_ptr();
  extern __shared__ __attribute__((aligned(16))) unsigned char lds_raw[];
  LAS unsigned char* lds = (LAS unsigned char*)lds_raw;
  cg::grid_group grid = cg::this_grid();
#ifndef REP_SYNC
#define REP_SYNC 1
#endif
#ifndef REP_P0
#define REP_P0 1
#endif
  unsigned bar_gen = 0; (void)bar_gen;
  volatile LAS unsigned* xb_st = (volatile LAS unsigned*)(lds + LDS_BYTES - 64);
  if (threadIdx.x < 4) xb_st[threadIdx.x] = 0u;
  __syncthreads();
  xb::XcdBarrier xbar = xb::xcd_barrier_post((unsigned*)(load_params(kp).ws + WS_XBAR), xb_st);
#ifndef PROF_SEAM
#define PROF_SEAM -1
#endif
  int seam_id = 0; (void)seam_id;
#ifndef PROF_PHASE
#define PROF_PHASE -1
#endif
  unsigned long long pp_prev = 0, pp_acc = 0; (void)pp_prev; (void)pp_acc;
#define QNEXT(qi, uvar) int uvar; { __syncthreads(); LAS unsigned* slot_ = (LAS unsigned*)(lds + LDS_BYTES - 16); \
    if (threadIdx.x == 0) *slot_ = __hip_atomic_fetch_add((unsigned*)(load_params(kp).ws + WS_BAR) + 16 + (qi), 1u, __ATOMIC_RELAXED, __HIP_MEMORY_SCOPE_AGENT); \
    __syncthreads(); uvar = __builtin_amdgcn_readfirstlane((int)*slot_); }
#define GSYNC() do { for (int rs_ = 0; rs_ < REP_SYNC; ++rs_) { ++bar_gen; xb::xcd_barrier(xbar); } } while (0)
  const int G = gridDim.x, bid = blockIdx.x;
#define IDS() const int tid = (int)threadIdx.x + opaque_zero(), lane = tid & 63, wv = tid >> 6, wave = __builtin_amdgcn_readfirstlane(wv); \
  const int gw = bid * 8 + wave, NGW = G * 8; (void)lane; (void)wv; (void)wave; (void)gw; (void)NGW;
#define LOADP() const P p = load_params(kp); bf16_t* H = (bf16_t*)(p.ws + WS_H); bf16_t* MIX = (bf16_t*)(p.ws + WS_MIX); bf16_t* PROJ = (bf16_t*)(p.ws + WS_PROJ); \
  bf16_t* YO = (bf16_t*)(p.ws + WS_PROJ); bf16_t* S5Y = (bf16_t*)(p.ws + WS_S5Y); const float* rc = (const float*)(p.ws + WS_ROPE); const float* rs = rc + SEQ * 32; \
  (void)H; (void)MIX; (void)PROJ; (void)YO; (void)S5Y; (void)rc; (void)rs;

#ifndef SKIP_P0
  for (int rep = 0; rep < REP_P0; ++rep) { IDS(); LOADP(); phase0(p, lds, tid, lane, wave); }
#endif
  if (load_params(kp).ws == nullptr) grid.sync();
  GSYNC();

#pragma unroll 1
  for (int layer = 0; layer < DEPTH; ++layer) {
#ifndef REP_P1
#define REP_P1 1
#endif
#ifndef REP_P5
#define REP_P5 1
#endif
#ifndef SKIP_P1
    for (int rep = 0; rep < REP_P1; ++rep) { LOADP();
      pg8::Gemm g{H, (const bf16_t*)(p.ws + WS_WIN) + (size_t)layer * NPAD * DM, MTOK, NPAD, DM};
      pg8::StaticOrder S; S.init(MTOK, NPAD, G, bid);
      EpiProj E{PROJ, rc, rs};
      pg8::gemm_phase<EpiProj, pg8::StaticOrder, true, true>(lds, g, S, E);
    }
#endif
    seam_id = 0;
    GSYNC();
#ifndef REP_P2
#define REP_P2 1
#endif
#ifndef REP_P3
#define REP_P3 1
#endif
#ifndef REP_P4
#define REP_P4 1
#endif
#ifndef SKIP_P2
    for (int rep = 0; rep < REP_P2; ++rep) {
      constexpr int U_KM = 64, U_S5 = 256, U_CONV = 512, U_MV = 128, U_SV = 64, U_DT = 64;
      constexpr int NU = U_KM + U_S5 + U_CONV + U_MV + U_SV + U_DT;
      for (;;) {
        QNEXT(rep * 16 + layer * 4 + 0, u); if (u >= NU) break;
        IDS(); LOADP();
        int r = u;
        if (r < U_KM) { kmean_unit(p, r, tid, lane, wv, lds); continue; } r -= U_KM;
        if (r < U_S5) { s5_m1_task(p, layer, r * 8 + wv, lane); continue; } r -= U_S5;
        if (r < U_CONV) { conv_unit(p, layer, r >> 1, r & 1, lane, wv); continue; } r -= U_CONV;
        if (r < U_MV) { vtrans_tile<16>(p, r * 128 + wv * 16, C_MV, lane * 8, 8, (bf16_t*)(p.ws + WS_MVT)); continue; } r -= U_MV;
        if (r < U_SV) { vtrans_tile<8>(p, r * 256 + (wv * 4 + (lane >> 4)) * 8, C_SV, (lane & 15) * 8, 2, (bf16_t*)(p.ws + WS_SVT)); continue; } r -= U_SV;
        dtscan_unit(p, layer, r, lane, wv);
      }
    }
#endif
    seam_id = 1;
    GSYNC();
#ifndef SKIP_P3
    for (int rep = 0; rep < REP_P3; ++rep) {
      constexpr int U_ST = 32, U_MOBA = 512, U_S5 = 256, U_SWA = 128;
      constexpr int NU = U_ST + U_MOBA + U_S5 + U_SWA;
      for (;;) {
        QNEXT(rep * 16 + layer * 4 + 1, u); if (u >= NU) break;
        IDS(); LOADP();
        int r = u;
        if (r < U_ST) { ssd_state_unit(p, r, lane, wv, tid, lds); continue; }
        r -= U_ST;
        if (r < 320 || r >= 320 + U_S5 + U_SWA) {
          const int rr = r < 320 ? r : r - (U_S5 + U_SWA);
          const int qb = 15 - (rr >> 5), h = rr & 7, b = (rr >> 3) & 3;
          moba_subunit(p, b, h, qb, wave, wv, lane, tid, lds);
          continue; }
        r -= 320;
        if (r < U_S5) { s5_m2_task(p, layer, r * 8 + wave, r * 8 + wv, lane, (LAS bf16_t*)(lds + wv * (32 * S5_XP * 2 + 4096))); continue; }
        r -= U_S5;
        { const int Q = 15 - (r & 15), kvh = (r >> 4) & 1, b = r >> 5; swa_unit(p, layer, b, kvh, Q, wave, wv, lane, tid, lds); }
      }
    }
#endif
    seam_id = 2;
    GSYNC();
#ifndef SKIP_P4
    for (int rep = 0; rep < REP_P4; ++rep) {
      for (;;) {
        QNEXT(rep * 16 + layer * 4 + 2, u); if (u >= 256 + 128) break;
        IDS(); LOADP();
        if (u < 256) {
          const int half = 1 - (u >> 7), rest = u & 127;
          ssd_out_unit(p, layer, (rest << 1) | half, lds, tid, lane, wave, wv);
        } else {
          const int t = u - 256;
          pg8::Gemm g{S5Y, (const bf16_t*)(p.ws + WS_GLU) + (size_t)layer * 512 * 512, MTOK, 512, 512, S5YP};
          OneUnit S{t >> 1, t & 1};
          EpiGlu E{MIX, S5Y, PROJ, p.glu_b + layer * 512};
          pg8::gemm_phase<EpiGlu, OneUnit, false, true>(lds, g, S, E);
        }
      }
    }
#endif
    seam_id = 3;
    GSYNC();
#ifndef SKIP_P5
    for (int rep = 0; rep < REP_P5; ++rep) { LOADP();
      pg8::Gemm g{MIX, (const bf16_t*)(p.ws + WS_WOUT) + (size_t)layer * DM * MIXW, MTOK, DM, MIXW};
      pg8::StaticOrder S; S.init(MTOK, DM, G, bid);
      EpiYo E{YO, DM};
      pg8::gemm_phase<EpiYo, pg8::StaticOrder, true, true>(lds, g, S, E);
    }
#endif
    seam_id = 4;
    GSYNC();
#ifndef REP_P6
#define REP_P6 1
#endif
    for (int rep = 0; rep < (layer == 0 ? REP_P6 : 1); ++rep) { IDS(); LOADP();
      const float* ng = layer + 1 < DEPTH ? p.pre_norm + (layer + 1) * DM : nullptr;
      bf16_t* XR = (bf16_t*)(p.ws + WS_XR);
      const float* pgp = p.post_norm + layer * DM;
      if (layer == 0) { for (int m = gw; m < MTOK; m += 2 * NGW) postnorm_rows<2, false, true>(YO, p.x, XR, pgp, ng, H, m, NGW, lane); }
      else if (layer + 1 < DEPTH) { for (int m = gw; m < MTOK; m += 2 * NGW) postnorm_rows<2, true, true>(YO, XR, XR, pgp, ng, H, m, NGW, lane); }
      else { for (int m = gw; m < MTOK; m += 2 * NGW) postnorm_rows<2, true, false>(YO, XR, p.out, pgp, ng, H, m, NGW, lane); }
    }
    seam_id = 5;
    if (layer + 1 < DEPTH) GSYNC();
  }
}

extern "C" void kernel_launch(void* const* d_in, const int* in_sizes, int n_in, void* d_out, int out_size,
                              void* d_ws, size_t ws_size, hipStream_t stream) {
  static int grid = 0;
  if (grid == 0) {
    if (n_in != 22 || out_size != MTOK * DM || ws_size < WS_END) { fprintf(stderr, "kernel_launch: unexpected shapes (n_in %d out %d ws %zu need %zu)\n", n_in, out_size, ws_size, (size_t)WS_END); grid = -1; return; }
    int dev = 0, cus = 0, per_cu = 0;
    (void)hipGetDevice(&dev);
    (void)hipDeviceGetAttribute(&cus, hipDeviceAttributeMultiprocessorCount, dev);
    (void)hipFuncSetAttribute((const void*)fwd_mega, hipFuncAttributeMaxDynamicSharedMemorySize, LDS_BYTES);
    (void)hipOccupancyMaxActiveBlocksPerMultiprocessor(&per_cu, (const void*)fwd_mega, 512, LDS_BYTES);
    if (per_cu < 1) per_cu = 1;
    if (per_cu > 1) per_cu = 1;
    grid = cus * per_cu;
    fprintf(stderr, "kernel_launch: grid %d, ws %zu (need %zu)\n", grid, ws_size, (size_t)WS_END);
  }
  if (grid < 0) return;
  P p{};
  const float** pp = (const float**)&p;
  for (int i = 0; i < 22; ++i) pp[i] = (const float*)d_in[i];
  p.out = (float*)d_out; p.ws = (unsigned char*)d_ws;
  (void)hipMemsetAsync((unsigned char*)d_ws + WS_BAR, 0, 1024 + 16384, stream);
  void* args[] = {&p};
  hipError_t e = hipLaunchCooperativeKernel((const void*)fwd_mega, dim3(grid), dim3(512), args, LDS_BYTES, stream);
  if (e != hipSuccess) fprintf(stderr, "kernel_launch: cooperative launch failed: %s (grid %d)\n", hipGetErrorString(e), grid);
}
```

```cpp
#include <hip/hip_runtime.h>
#include <hip/hip_cooperative_groups.h>
#include <cstdio>
#include <cstdint>
namespace cg = cooperative_groups;
__device__ __forceinline__ int opaque_zero() { int z = 0; asm volatile("" : "+v"(z)); return z; }
namespace pg8 {
#define PG8_LAS __attribute__((address_space(3)))
typedef unsigned short bf16_t;
typedef short bf16x8 __attribute__((ext_vector_type(8)));
typedef float f32x4 __attribute__((ext_vector_type(4)));
typedef unsigned u32x4 __attribute__((ext_vector_type(4)));
constexpr int BM = 256, BK = 64, HALF = 128, HTB = HALF * BK * 2  , STAGE_BYTES = 8 * HTB, NXCD = 8, WGM = 8;

__host__ __device__ __forceinline__ int lds_byte(int r, int c) { const int st = (r >> 4) * 2 + (c >> 5), rr = r & 15, cc = c & 31, ob = rr * 64 + cc * 2; return st * 1024 + (ob ^ (((ob >> 9) & 1) << 5)); }
__host__ __device__ __forceinline__ void stage_rc(int b, int& R, int& C) { const int st = b / 1024, sb = b % 1024, swz = sb ^ (((sb >> 9) & 1) << 5); R = (st >> 1) * 16 + swz / 64; C = (st & 1) * 32 + (swz % 64) / 2; }
__host__ __device__ __forceinline__ int perm32(int rho) { const int n = rho >> 4, i = rho & 15; return 8 * (i >> 2) + 4 * n + (i & 3); }

struct Unit { int pm, pn; };
struct Gemm { const bf16_t* A; const bf16_t* Bt; int M, N, K; int lda = 0; };

struct StaticOrder {
    int nM, nN, nwg, G, c;
    __host__ __device__ void init(int M, int N, int G_, int c_) { nM = M / BM; nN = N / BM; nwg = nM * nN; G = G_; c = c_; }
    __host__ __device__ bool next(int i, Unit& u) const {
        const long L = (long)i * G + c; if (L >= nwg) return false;
        int wgid = (int)L; { const int q = nwg / NXCD, r = nwg % NXCD, xcd = wgid % NXCD, off = wgid / NXCD; wgid = (xcd < r ? xcd * (q + 1) : r * (q + 1) + (xcd - r) * q) + off; }
        const int nig = WGM * nN, gid = wgid / nig, fm = gid * WGM, gsz = (nM - fm) < WGM ? (nM - fm) : WGM;
        u.pm = fm + ((wgid % nig) % gsz); u.pn = (wgid % nig) / gsz; return true;
    }
    __device__ __forceinline__ void a_ready(const Unit&) const {}
    __device__ __forceinline__ void done(const Unit&) const {}
};
__device__ __forceinline__ unsigned cvt_pk_bf16(float lo, float hi) { unsigned r; asm volatile("v_cvt_pk_bf16_f32 %0, %1, %2" : "=v"(r) : "v"(lo), "v"(hi)); return r; }

template <class Epi, class Sched, bool ALIGN_EPI = false, bool SP2 = false>
__device__ __forceinline__ void gemm_phase(PG8_LAS unsigned char* lds, const Gemm g, const Sched& S, const Epi& E) {
    const int tid = (int)threadIdx.x + opaque_zero(), wid = __builtin_amdgcn_readfirstlane(tid >> 6), lane = tid & 63, wr = wid >> 2, wc = wid & 3, fr = lane & 15, fq = lane >> 4;
    const int K = g.K, nt = K / BK, lda = g.lda ? g.lda : g.K;
    unsigned voffA[2], voffB[2];
#pragma unroll
    for (int i = 0; i < 2; ++i) { int R, C; stage_rc(tid * 16 + i * 8192, R, C); const int Rb = Epi::PERM ? ((R & ~31) + perm32(R & 31)) : R;
        voffA[i] = (unsigned)(R * lda + C) * 2u; voffB[i] = (unsigned)(Rb * K + C) * 2u; }
    const size_t kstep = (size_t)(BK * 2);
    const size_t hstepA = (size_t)HALF * lda * 2, hstepB = (size_t)HALF * K * 2;
    const size_t tstepA = 2 * hstepA, tstepB = 2 * hstepB;
    const unsigned ldsw = (unsigned)wid * 1024u;
    const int aoff = lds_byte(wr * 64 + fr, fq * 8), boff = lds_byte(wc * 32 + fr, fq * 8);
#define PG8_SA(b, h) (((b) * 2 + (h)) * HTB)
#define PG8_SB(b, h) ((4 + (b) * 2 + (h)) * HTB)
#define PG8_STAGE(bufoff, gbase, voff) do { _Pragma("unroll") for (int _i = 0; _i < 2; ++_i) \
        __builtin_amdgcn_global_load_lds((const unsigned*)((const char*)(gbase) + (voff)[_i]), (PG8_LAS unsigned*)(lds + (bufoff) + ldsw + _i * 8192), 16, 0, 0); } while (0)
#define PG8_LDA(dst, b, h) do { _Pragma("unroll") for (int m = 0; m < 4; ++m) _Pragma("unroll") for (int k = 0; k < 2; ++k) dst[m][k] = *(const PG8_LAS bf16x8*)(lds + PG8_SA(b, h) + aoff + m * 2048 + k * 1024); } while (0)
#define PG8_LDB(dst, b, h) do { _Pragma("unroll") for (int n = 0; n < 2; ++n) _Pragma("unroll") for (int k = 0; k < 2; ++k) dst[n][k] = *(const PG8_LAS bf16x8*)(lds + PG8_SB(b, h) + boff + n * 2048 + k * 1024); } while (0)
#define PG8_MMA(ai, bj, At, Bt) do { __builtin_amdgcn_s_setprio(1); _Pragma("unroll") for (int m = 0; m < 4; ++m) _Pragma("unroll") for (int n = 0; n < 2; ++n) _Pragma("unroll") for (int k = 0; k < 2; ++k) \
        acc[ai][bj][m][n] = __builtin_amdgcn_mfma_f32_16x16x32_bf16(Bt[n][k], At[m][k], acc[ai][bj][m][n], 0, 0, 0); __builtin_amdgcn_s_setprio(0); } while (0)
#define PG8_WAIT_V(n) asm volatile("s_waitcnt vmcnt(" #n ")" ::: "memory")
#define PG8_WAIT_L(n) asm volatile("s_waitcnt lgkmcnt(" #n ")" ::: "memory")
#define PG8_BAR __builtin_amdgcn_s_barrier()
#define PG8_SCHED __builtin_amdgcn_sched_barrier(0)
    Unit cur, nxt; int ui = 0;
    if (!S.next(0, cur)) return;
    f32x4 acc[2][2][4][2];
#pragma unroll
    for (int a = 0; a < 2; ++a)
#pragma unroll
        for (int b = 0; b < 2; ++b)
#pragma unroll
            for (int m = 0; m < 4; ++m)
#pragma unroll
                for (int n = 0; n < 2; ++n) acc[a][b][m][n] = (f32x4){0.f, 0.f, 0.f, 0.f};
    bf16x8 At[4][2], B0[2][2], B1[2][2];
    const char* cA = (const char*)g.A + (size_t)cur.pm * tstepA; const char* cB = (const char*)g.Bt + (size_t)cur.pn * tstepB;
    S.a_ready(cur);
    if constexpr (SP2) {
        PG8_STAGE(PG8_SB(0, 0), cB, voffB); PG8_STAGE(PG8_SB(0, 1), cB + hstepB, voffB); PG8_STAGE(PG8_SA(0, 0), cA, voffA); PG8_STAGE(PG8_SA(0, 1), cA + hstepA, voffA);
        if (wr == 1) PG8_BAR;
        PG8_WAIT_V(2); PG8_BAR;
        PG8_STAGE(PG8_SB(1, 0), cB + kstep, voffB); PG8_STAGE(PG8_SA(1, 0), cA + kstep, voffA); PG8_STAGE(PG8_SB(1, 1), cB + hstepB + kstep, voffB);
        PG8_WAIT_V(6); PG8_BAR;
    } else {
        PG8_STAGE(PG8_SB(0, 0), cB, voffB); PG8_STAGE(PG8_SA(0, 0), cA, voffA); PG8_STAGE(PG8_SB(0, 1), cB + hstepB, voffB); PG8_STAGE(PG8_SA(0, 1), cA + hstepA, voffA);
        if (wr == 1) PG8_BAR;
        PG8_WAIT_V(4); PG8_BAR;
        PG8_STAGE(PG8_SB(1, 0), cB + kstep, voffB); PG8_STAGE(PG8_SA(1, 0), cA + kstep, voffA); PG8_STAGE(PG8_SB(1, 1), cB + hstepB + kstep, voffB);
        PG8_WAIT_V(6); PG8_BAR;
    }
    for (;;) {
        const bool has_next = S.next(ui + 1, nxt);
        const char* nA = has_next ? (const char*)g.A + (size_t)nxt.pm * tstepA : cA; const char* nB = has_next ? (const char*)g.Bt + (size_t)nxt.pn * tstepB : cB;
        for (int t = 0; t < nt; t += 2) {
            const bool last = (t == nt - 2);
            const char* a1 = cA + (size_t)(t + 1) * kstep;
            const char* a2 = last ? nA : cA + (size_t)(t + 2) * kstep; const char* b2 = last ? nB : cB + (size_t)(t + 2) * kstep;
            const char* a3 = a2 + kstep; const char* b3 = b2 + kstep;
            if (last && has_next) S.a_ready(nxt);
            if constexpr (SP2) {
            PG8_LDB(B0, 0, 0); PG8_LDB(B1, 0, 1); PG8_SCHED; PG8_LDA(At, 0, 0); PG8_STAGE(PG8_SA(1, 1), a1 + hstepA, voffA);
            PG8_WAIT_V(8); PG8_WAIT_L(0); PG8_BAR; PG8_MMA(0, 0, At, B0); PG8_MMA(0, 1, At, B1); PG8_BAR; PG8_SCHED;
            PG8_LDA(At, 0, 1); PG8_STAGE(PG8_SB(0, 0), b2, voffB); PG8_STAGE(PG8_SB(0, 1), b2 + hstepB, voffB); PG8_STAGE(PG8_SA(0, 0), a2, voffA);
            PG8_WAIT_V(8); PG8_WAIT_L(0); PG8_BAR; PG8_MMA(1, 0, At, B0); PG8_MMA(1, 1, At, B1); PG8_BAR; PG8_SCHED;
            PG8_LDB(B0, 1, 0); PG8_LDB(B1, 1, 1); PG8_SCHED; PG8_LDA(At, 1, 0); PG8_STAGE(PG8_SA(0, 1), a2 + hstepA, voffA);
            PG8_WAIT_V(8); PG8_WAIT_L(0); PG8_BAR; PG8_MMA(0, 0, At, B0); PG8_MMA(0, 1, At, B1); PG8_BAR; PG8_SCHED;
            PG8_LDA(At, 1, 1); PG8_STAGE(PG8_SB(1, 0), b3, voffB); PG8_STAGE(PG8_SB(1, 1), b3 + hstepB, voffB); PG8_STAGE(PG8_SA(1, 0), a3, voffA);
            PG8_WAIT_V(8); PG8_WAIT_L(0); PG8_BAR; PG8_MMA(1, 0, At, B0); PG8_MMA(1, 1, At, B1); PG8_BAR; PG8_SCHED;
            } else {
            PG8_LDB(B0, 0, 0); PG8_SCHED; PG8_LDA(At, 0, 0); PG8_STAGE(PG8_SA(1, 1), a1 + hstepA, voffA);
            PG8_WAIT_L(8); PG8_BAR; PG8_WAIT_L(0); PG8_MMA(0, 0, At, B0); PG8_BAR; PG8_SCHED;
            PG8_LDB(B1, 0, 1); PG8_STAGE(PG8_SB(0, 0), b2, voffB);
            PG8_BAR; PG8_WAIT_L(0); PG8_MMA(0, 1, At, B1); PG8_BAR;
            PG8_LDA(At, 0, 1); PG8_STAGE(PG8_SA(0, 0), a2, voffA);
            PG8_BAR; PG8_WAIT_L(0); PG8_MMA(1, 0, At, B0); PG8_BAR; PG8_SCHED;
            PG8_STAGE(PG8_SB(0, 1), b2 + hstepB, voffB);
            PG8_WAIT_V(6); PG8_BAR; PG8_MMA(1, 1, At, B1); PG8_BAR;
            PG8_LDB(B0, 1, 0); PG8_SCHED; PG8_LDA(At, 1, 0); PG8_STAGE(PG8_SA(0, 1), a2 + hstepA, voffA);
            PG8_WAIT_L(8); PG8_BAR; PG8_WAIT_L(0); PG8_MMA(0, 0, At, B0); PG8_BAR; PG8_SCHED;
            PG8_LDB(B1, 1, 1); PG8_STAGE(PG8_SB(1, 0), b3, voffB);
            PG8_BAR; PG8_WAIT_L(0); PG8_MMA(0, 1, At, B1); PG8_BAR;
            PG8_LDA(At, 1, 1); PG8_STAGE(PG8_SA(1, 0), a3, voffA);
            PG8_BAR; PG8_WAIT_L(0); PG8_MMA(1, 0, At, B0); PG8_BAR; PG8_SCHED;
            PG8_STAGE(PG8_SB(1, 1), b3 + hstepB, voffB);
            PG8_WAIT_V(6); PG8_BAR; PG8_MMA(1, 1, At, B1); PG8_BAR;
            }
        }
        if constexpr (ALIGN_EPI) { if (wr == 0) PG8_BAR; }
        if constexpr (!Epi::AFTER_DRAIN) { E(acc, cur, wr, wc, fr, fq); S.done(cur); }
        if (!has_next) break;
#pragma unroll
        for (int a = 0; a < 2; ++a)
#pragma unroll
            for (int b = 0; b < 2; ++b)
#pragma unroll
                for (int m = 0; m < 4; ++m)
#pragma unroll
                    for (int n = 0; n < 2; ++n) acc[a][b][m][n] = (f32x4){0.f, 0.f, 0.f, 0.f};
        cur = nxt; cA = nA; cB = nB; ++ui;
        if constexpr (ALIGN_EPI) { if (wr == 1) PG8_BAR; }
    }
    PG8_WAIT_V(0);
    if constexpr (!ALIGN_EPI) { if (wr == 0) PG8_BAR; }
    PG8_BAR;
    if constexpr (Epi::AFTER_DRAIN) { E.fused(acc, cur, wr, wc, fr, fq, lds, wid, lane); S.done(cur); }
#undef PG8_SA
#undef PG8_SB
#undef PG8_STAGE
#undef PG8_LDA
#undef PG8_LDB
#undef PG8_MMA
#undef PG8_WAIT_V
#undef PG8_WAIT_L
#undef PG8_BAR
#undef PG8_SCHED
}
}

#define LAS __attribute__((address_space(3)))
typedef unsigned short bf16_t;
typedef short bf16x8 __attribute__((ext_vector_type(8)));
typedef short bf16x4 __attribute__((ext_vector_type(4)));
typedef float f32x4 __attribute__((ext_vector_type(4)));
typedef float f32x16 __attribute__((ext_vector_type(16)));
typedef unsigned u32x4 __attribute__((ext_vector_type(4)));
typedef unsigned u32x2 __attribute__((ext_vector_type(2)));

constexpr int NB = 4, SEQ = 4096, DM = 2048, DEPTH = 4, MTOK = NB * SEQ;
constexpr int IN_W = 5896, NPAD = 6144, LDP = NPAD + 64, MIXW = 2048;
constexpr int C_MQ = 0, C_MK = 512, C_MV = 1024, C_MG = 1536, C_XBC = 2048, C_Z = 3072, C_SQ = 3584, C_SK = 4096, C_SV = 4224,
              C_SG = 4352, C_SU = 4864, C_S5G = 5376, C_DT = 5888;
constexpr float NORM_EPS = 1e-6f;
constexpr float LOG2E = 1.4426950408889634f;
constexpr float QSCALE = 0.125f * LOG2E;

constexpr size_t SZ_WIN = (size_t)DEPTH * NPAD * DM * 2, SZ_WOUT = (size_t)DEPTH * DM * MIXW * 2, SZ_GLU = (size_t)DEPTH * 512 * 512 * 2;
constexpr size_t WS_WIN = 0;
constexpr size_t WS_WOUT = WS_WIN + SZ_WIN;
constexpr size_t WS_GLU = WS_WOUT + SZ_WOUT;
constexpr size_t WS_H = WS_GLU + SZ_GLU;
constexpr size_t WS_MIX = WS_H + (size_t)MTOK * DM * 2;
constexpr size_t WS_PROJ = WS_MIX + (size_t)MTOK * MIXW * 2;
constexpr size_t WS_XC = WS_PROJ + (size_t)MTOK * LDP * 2;
constexpr size_t WS_XDT = WS_XC + (size_t)MTOK * 1024 * 2;
constexpr size_t WS_BT = WS_XDT + (size_t)NB * 8 * 64 * SEQ * 2;
constexpr size_t WS_MVT = WS_BT + (size_t)NB * 2 * 128 * SEQ * 2;
constexpr size_t WS_SVT = WS_MVT + (size_t)NB * 8 * 64 * SEQ * 2;
constexpr size_t WS_DTV = WS_SVT + (size_t)NB * 2 * 64 * SEQ * 2;
constexpr size_t WS_ACUM = WS_DTV + (size_t)NB * 8 * SEQ * 4;
constexpr size_t WS_CS = WS_ACUM + (size_t)NB * 8 * SEQ * 4;
constexpr size_t WS_KMEAN = WS_CS + (size_t)NB * 16 * 8 * 8192 * 4;
constexpr size_t WS_S5E = WS_KMEAN + (size_t)NB * 8 * 16 * 64 * 4;
constexpr size_t WS_S5Y = WS_S5E + (size_t)NB * 32 * 16 * 64 * 8;
constexpr int S5YP = 576;
constexpr size_t WS_ROPE = WS_S5Y + (size_t)MTOK * S5YP * 2;
constexpr size_t WS_BAR = WS_ROPE + (size_t)SEQ * 32 * 4 * 2;
constexpr size_t WS_XBAR = WS_BAR + 1024;
constexpr size_t WS_XR = WS_XBAR + 16384;
constexpr size_t WS_END = WS_XR + (size_t)MTOK * DM * 2;

constexpr int LDS_BYTES = 144 * 1024;

struct P {
  const float *x, *pre_norm, *post_norm, *w_in, *w_out, *conv_w, *conv_b, *dt_bias, *a_log, *ssd_d, *ssd_norm, *sinks,
      *a_re, *a_im, *log_dt, *b_re, *b_im, *c_re, *c_im, *s5_d, *glu_w, *glu_b;
  float* out; unsigned char* ws;
};

typedef const __attribute__((address_space(4))) P* KP;
__device__ __forceinline__ P load_params(unsigned long long a) {
  asm volatile("" : "+s"(a));
  KP q = (KP)a;
  P p;
  p.x = q->x; p.pre_norm = q->pre_norm; p.post_norm = q->post_norm; p.w_in = q->w_in; p.w_out = q->w_out; p.conv_w = q->conv_w; p.conv_b = q->conv_b;
  p.dt_bias = q->dt_bias; p.a_log = q->a_log; p.ssd_d = q->ssd_d; p.ssd_norm = q->ssd_norm; p.sinks = q->sinks; p.a_re = q->a_re; p.a_im = q->a_im;
  p.log_dt = q->log_dt; p.b_re = q->b_re; p.b_im = q->b_im; p.c_re = q->c_re; p.c_im = q->c_im; p.s5_d = q->s5_d; p.glu_w = q->glu_w; p.glu_b = q->glu_b;
  p.out = q->out; p.ws = q->ws;
  return p;
}

__device__ __forceinline__ float bf2f(unsigned short v) { return __builtin_bit_cast(float, (unsigned)v << 16); }
__device__ __forceinline__ float bflo(unsigned w) { return __builtin_bit_cast(float, w << 16); }
__device__ __forceinline__ float bfhi(unsigned w) { return __builtin_bit_cast(float, w & 0xffff0000u); }
__device__ __forceinline__ unsigned short f2bf(float f) { unsigned u = __builtin_bit_cast(unsigned, f); return (unsigned short)((u + 0x7fffu + ((u >> 16) & 1u)) >> 16); }
__device__ __forceinline__ unsigned pk2(float lo, float hi) { return pg8::cvt_pk_bf16(lo, hi); }
__device__ __forceinline__ float wave_sum(float v) {
#pragma unroll
  for (int o = 1; o < 64; o <<= 1) v += __shfl_xor(v, o);
  return v;
}
__device__ __forceinline__ float fexp2(float x) { return __builtin_amdgcn_exp2f(x); }
__device__ __forceinline__ float fexp(float x) { return __builtin_amdgcn_exp2f(x * LOG2E); }
__device__ __forceinline__ float silu_f(float x) { return x * __builtin_amdgcn_rcpf(1.f + fexp(-x)); }
__device__ __forceinline__ float sigmoid_f(float x) { return __builtin_amdgcn_rcpf(1.f + fexp(-x)); }
__device__ __forceinline__ float softplus_f(float x) {
  const float e = fexp(-fabsf(x));
  const float l = (e < 0.03125f) ? e * (1.f - e * (0.5f - e * (0.33333333f - 0.25f * e))) : __logf(1.f + e);
  return fmaxf(x, 0.f) + l;
}
__device__ __forceinline__ float gelu_tanh_f(float x) {
  const float u = 0.7978845608028654f * (x + 0.044715f * x * x * x);
  const float t = 1.f - 2.f * __builtin_amdgcn_rcpf(1.f + fexp(2.f * u));
  return 0.5f * x * (1.f + t);
}
#define MFMA32(a, b, c) __builtin_amdgcn_mfma_f32_32x32x16_bf16((a), (b), (c), 0, 0, 0)
__device__ __forceinline__ int crow(int reg, int hf) { return (reg & 3) + 8 * (reg >> 2) + 4 * hf; }

__device__ __forceinline__ int il64(int j) { return ((j & 1) << 5) + (j >> 1); }
__device__ __forceinline__ int map_in_col(int n) {
  if (n < 1024) return (n & ~63) + il64(n & 63);
  if (n < 3072) return n;
  if (n < C_SQ) return n + 8;
  if (n < C_SV) { const int q = n - C_SQ; return 3592 + (q & ~63) + il64(q & 63); }
  if (n < C_DT) return n + 8;
  if (n < C_DT + 8) return 3072 + (n - C_DT);
  return -1;
}

__device__ __forceinline__ void transpose_item(const float* W, int K, int N, bf16_t* WT, int n0, int k0, bool mapped, LAS float* scr, int lane) {
  const int nl = lane & 31;
  const int nsrc = mapped ? map_in_col(n0 + nl) : (n0 + nl);
  float wv_[32];
#pragma unroll
  for (int i = 0; i < 32; ++i) { const int kk = 2 * i + (lane >> 5); wv_[i] = nsrc >= 0 ? W[(size_t)(k0 + kk) * N + nsrc] : 0.f; }
#pragma unroll
  for (int i = 0; i < 32; ++i) { const int kk = 2 * i + (lane >> 5); scr[kk * 33 + nl] = wv_[i]; }
  asm volatile("s_waitcnt lgkmcnt(0)" ::: "memory");
  const int c = lane & 7;
#pragma unroll
  for (int j = 0; j < 4; ++j) { const int n = (lane >> 3) + 8 * j; const LAS float* s = scr + (8 * c) * 33 + n;
    u32x4 o; o.x = pk2(s[0 * 33], s[1 * 33]); o.y = pk2(s[2 * 33], s[3 * 33]); o.z = pk2(s[4 * 33], s[5 * 33]); o.w = pk2(s[6 * 33], s[7 * 33]);
    *(u32x4*)(WT + (size_t)(n0 + n) * K + k0 + 8 * c) = o; }
  asm volatile("s_waitcnt lgkmcnt(0)" ::: "memory");
}

__device__ __forceinline__ void prenorm_row(const float* xrow, const float* g, bf16_t* hrow, int lane) {
  f32x4 v[8]; float ss = 0.f;
#pragma unroll
  for (int j = 0; j < 8; ++j) { v[j] = *(const f32x4*)(xrow + 4 * lane + 256 * j); ss += v[j].x * v[j].x + v[j].y * v[j].y + v[j].z * v[j].z + v[j].w * v[j].w; }
  const float rstd = 1.f / sqrtf(wave_sum(ss) * (1.f / DM) + NORM_EPS);
#pragma unroll
  for (int j = 0; j < 8; ++j) { const f32x4 gg = *(const f32x4*)(g + 4 * lane + 256 * j);
    u32x2 o; o.x = pk2(v[j].x * rstd * gg.x, v[j].y * rstd * gg.y); o.y = pk2(v[j].z * rstd * gg.z, v[j].w * rstd * gg.w);
    *(u32x2*)(hrow + 4 * lane + 256 * j) = o; }
}

__device__ __forceinline__ void phase0(const P& p, LAS unsigned char* lds, int tid, int lane, int wave) {
  LAS float* scr = (LAS float*)(lds + wave * 16384);
  const int gw = blockIdx.x * 8 + wave, NGW = gridDim.x * 8;
  bf16_t* WIN = (bf16_t*)(p.ws + WS_WIN); bf16_t* WOUT = (bf16_t*)(p.ws + WS_WOUT); bf16_t* GLU = (bf16_t*)(p.ws + WS_GLU);
  constexpr int I_IN = (DM / 64) * (NPAD / 32), I_OUT = (MIXW / 64) * (DM / 32), I_GLU = (512 / 64) * (512 / 32), I_L = I_IN + I_OUT + I_GLU;
  for (int it = gw; it < DEPTH * I_L; it += NGW) {
    const int l = it / I_L; int r = it % I_L;
    if (r < I_IN) { const int nb = r % (NPAD / 32), kb = r / (NPAD / 32);
      transpose_item(p.w_in + (size_t)l * DM * IN_W, DM, IN_W, WIN + (size_t)l * NPAD * DM, nb * 32, kb * 64, true, scr, lane); continue; }
    r -= I_IN;
    if (r < I_OUT) { const int nb = r % (DM / 32), kb = r / (DM / 32);
      transpose_item(p.w_out + (size_t)l * MIXW * DM, MIXW, DM, WOUT + (size_t)l * DM * MIXW, nb * 32, kb * 64, false, scr, lane); continue; }
    r -= I_OUT;
    { const int nb = r % 16, kb = r / 16;
      transpose_item(p.glu_w + (size_t)l * 512 * 512, 512, 512, GLU + (size_t)l * 512 * 512, nb * 32, kb * 64, false, scr, lane); }
  }
  float* rc = (float*)(p.ws + WS_ROPE); float* rs = rc + SEQ * 32;
  for (int i = blockIdx.x * 512 + tid; i < SEQ * 32; i += gridDim.x * 512) {
    const int pos = i >> 5, f = i & 31;
    const float inv = 1.0f / powf(10000.f, (float)(2 * f) / 64.f);
    const float ang = (float)pos * inv;
    rc[i] = cosf(ang); rs[i] = sinf(ang);
  }
  bf16_t* H = (bf16_t*)(p.ws + WS_H);
  for (int m = gw; m < MTOK; m += 2 * NGW) {
    const float* x0 = p.x + (size_t)m * DM; const float* x1 = p.x + (size_t)(m + NGW) * DM;
    f32x4 v0[8], v1[8]; float s0 = 0.f, s1 = 0.f;
#pragma unroll
    for (int j = 0; j < 8; ++j) { v0[j] = *(const f32x4*)(x0 + 4 * lane + 256 * j); v1[j] = *(const f32x4*)(x1 + 4 * lane + 256 * j); }
#pragma unroll
    for (int j = 0; j < 8; ++j) { s0 += v0[j].x * v0[j].x + v0[j].y * v0[j].y + v0[j].z * v0[j].z + v0[j].w * v0[j].w; s1 += v1[j].x * v1[j].x + v1[j].y * v1[j].y + v1[j].z * v1[j].z + v1[j].w * v1[j].w; }
    const float r0 = 1.f / sqrtf(wave_sum(s0) * (1.f / DM) + NORM_EPS), r1 = 1.f / sqrtf(wave_sum(s1) * (1.f / DM) + NORM_EPS);
#pragma unroll
    for (int j = 0; j < 8; ++j) { const f32x4 gg = *(const f32x4*)(p.pre_norm + 4 * lane + 256 * j);
      u32x2 o0, o1; o0.x = pk2(v0[j].x * r0 * gg.x, v0[j].y * r0 * gg.y); o0.y = pk2(v0[j].z * r0 * gg.z, v0[j].w * r0 * gg.w);
      o1.x = pk2(v1[j].x * r1 * gg.x, v1[j].y * r1 * gg.y); o1.y = pk2(v1[j].z * r1 * gg.z, v1[j].w * r1 * gg.w);
      *(u32x2*)(H + (size_t)m * DM + 4 * lane + 256 * j) = o0; *(u32x2*)(H + (size_t)(m + NGW) * DM + 4 * lane + 256 * j) = o1; }
  }
}

struct EpiProj {
  static constexpr bool PERM = true, AFTER_DRAIN = false;
  bf16_t* O; const float* rc; const float* rs;
  __device__ __forceinline__ void operator()(const pg8::f32x4 (&acc)[2][2][4][2], const pg8::Unit& u, int wr, int wc, int fr_, int fq_) const {
    const int ln = (int)(threadIdx.x & 63) + opaque_zero(); const int fr = ln & 15, fq = ln >> 4;
    const int row0 = u.pm * 256 + wr * 64 + fr;
#pragma unroll
    for (int bj = 0; bj < 2; ++bj) {
      const int cb = u.pn * 256 + bj * 128;
      int mode = 0;
      if (cb < C_MK) mode = 2; else if (cb < C_MV) mode = 1; else if (cb >= C_SQ && cb < C_SK) mode = 2; else if (cb >= C_SK && cb < C_SV) mode = 1;
      const int col0 = cb + wc * 32 + 8 * fq;
      const int i0 = 16 * (wc & 1) + 4 * fq;
#pragma unroll
      for (int ai = 0; ai < 2; ++ai)
#pragma unroll
        for (int m = 0; m < 4; ++m) {
          const int row = row0 + ai * 128 + m * 16;
          f32x4 v0 = acc[ai][bj][m][0], v1 = acc[ai][bj][m][1];
          if (mode) {
            const int pos = row & (SEQ - 1);
            const f32x4 c = *(const f32x4*)(rc + pos * 32 + i0), s = *(const f32x4*)(rs + pos * 32 + i0);
            const float sc = (mode == 2) ? QSCALE : 1.f;
            f32x4 a, b;
            a[0] = (v0[0] * c[0] - v0[1] * s[0]) * sc; a[1] = (v0[1] * c[0] + v0[0] * s[0]) * sc;
            a[2] = (v0[2] * c[1] - v0[3] * s[1]) * sc; a[3] = (v0[3] * c[1] + v0[2] * s[1]) * sc;
            b[0] = (v1[0] * c[2] - v1[1] * s[2]) * sc; b[1] = (v1[1] * c[2] + v1[0] * s[2]) * sc;
            b[2] = (v1[2] * c[3] - v1[3] * s[3]) * sc; b[3] = (v1[3] * c[3] + v1[2] * s[3]) * sc;
            v0 = a; v1 = b;
          }
          u32x4 w; w.x = pk2(v0[0], v0[1]); w.y = pk2(v0[2], v0[3]); w.z = pk2(v1[0], v1[1]); w.w = pk2(v1[2], v1[3]);
          *(u32x4*)(O + (size_t)row * LDP + col0) = w;
        }
    }
  }
};

struct EpiYo {
  static constexpr bool PERM = true, AFTER_DRAIN = false;
  bf16_t* O; int ldc;
  __device__ __forceinline__ void operator()(const pg8::f32x4 (&acc)[2][2][4][2], const pg8::Unit& u, int wr, int wc, int fr_, int fq_) const {
    const int ln = (int)(threadIdx.x & 63) + opaque_zero(); const int fr = ln & 15, fq = ln >> 4;
    const int row0 = u.pm * 256 + wr * 64 + fr;
#pragma unroll
    for (int ai = 0; ai < 2; ++ai)
#pragma unroll
      for (int m = 0; m < 4; ++m) {
        bf16_t* rp = O + (size_t)(row0 + ai * 128 + m * 16) * ldc + u.pn * 256 + wc * 32 + 8 * fq;
#pragma unroll
        for (int bj = 0; bj < 2; ++bj) { const pg8::f32x4 v0 = acc[ai][bj][m][0], v1 = acc[ai][bj][m][1];
          u32x4 w; w.x = pk2(v0[0], v0[1]); w.y = pk2(v0[2], v0[3]); w.z = pk2(v1[0], v1[1]); w.w = pk2(v1[2], v1[3]);
          *(u32x4*)(rp + bj * 128) = w; }
      }
  }
};

struct EpiGlu {
  static constexpr bool PERM = true, AFTER_DRAIN = false;
  bf16_t* MIX; const bf16_t* Y; const bf16_t* PROJ; const float* bias;
  __device__ __forceinline__ void operator()(const pg8::f32x4 (&acc)[2][2][4][2], const pg8::Unit& u, int wr, int wc, int fr_, int fq_) const {
    const int ln = (int)(threadIdx.x & 63) + opaque_zero(); const int fr = ln & 15, fq = ln >> 4;
    const int row0 = u.pm * 256 + wr * 64 + fr;
#pragma unroll
    for (int bj = 0; bj < 2; ++bj) {
      const int col0 = u.pn * 256 + bj * 128 + wc * 32 + 8 * fq;
      const f32x4 b0 = *(const f32x4*)(bias + col0), b1 = *(const f32x4*)(bias + col0 + 4);
#pragma unroll
      for (int ai = 0; ai < 2; ++ai)
#pragma unroll
        for (int m = 0; m < 4; ++m) {
          const int row = row0 + ai * 128 + m * 16;
          bf16_t* mp = MIX + (size_t)row * MIXW + 1536 + col0;
          const u32x4 mv = *(const u32x4*)mp;
          const f32x4 a0 = acc[ai][bj][m][0] + b0, a1 = acc[ai][bj][m][1] + b1;
          u32x4 w;
          w.x = pk2(bflo(mv.x) * sigmoid_f(a0[0]), bfhi(mv.x) * sigmoid_f(a0[1])); w.y = pk2(bflo(mv.y) * sigmoid_f(a0[2]), bfhi(mv.y) * sigmoid_f(a0[3]));
          w.z = pk2(bflo(mv.z) * sigmoid_f(a1[0]), bfhi(mv.z) * sigmoid_f(a1[1])); w.w = pk2(bflo(mv.w) * sigmoid_f(a1[2]), bfhi(mv.w) * sigmoid_f(a1[3]));
          *(u32x4*)mp = w;
        }
    }
  }
};

struct OneUnit {
  int pm, pn;
  __device__ __forceinline__ bool next(int i, pg8::Unit& u) const { if (i != 0) return false; u.pm = pm; u.pn = pn; return true; }
  __device__ __forceinline__ void a_ready(const pg8::Unit&) const {}
  __device__ __forceinline__ void done(const pg8::Unit&) const {}
};
__device__ __forceinline__ void unpack8(const u32x4 v, float (&f)[8]) {
  f[0] = bflo(v.x); f[1] = bfhi(v.x); f[2] = bflo(v.y); f[3] = bfhi(v.y); f[4] = bflo(v.z); f[5] = bfhi(v.z); f[6] = bflo(v.w); f[7] = bfhi(v.w);
}
__device__ __forceinline__ void conv_unit(const P& p, int layer, int rt, int cb, int lane, int wv) {
  const bf16_t* PROJ = (const bf16_t*)(p.ws + WS_PROJ); bf16_t* XC = (bf16_t*)(p.ws + WS_XC);
  const int col0 = cb * 512 + lane * 8, g0 = rt * 64 + wv * 8, b = g0 >> 12, t0 = g0 & (SEQ - 1);
  const float* cw = p.conv_w + (size_t)layer * 4 * 1024 + col0;
  float w0[8], w1[8], w2[8], w3[8], cbv[8];
  { const f32x4 a0 = *(const f32x4*)cw, a1 = *(const f32x4*)(cw + 4), b0 = *(const f32x4*)(cw + 1024), b1 = *(const f32x4*)(cw + 1028),
      c0 = *(const f32x4*)(cw + 2048), c1 = *(const f32x4*)(cw + 2052), d0 = *(const f32x4*)(cw + 3072), d1 = *(const f32x4*)(cw + 3076);
    const f32x4 e0 = *(const f32x4*)(p.conv_b + layer * 1024 + col0), e1 = *(const f32x4*)(p.conv_b + layer * 1024 + col0 + 4);
#pragma unroll
    for (int e = 0; e < 4; ++e) { w0[e] = a0[e]; w0[4 + e] = a1[e]; w1[e] = b0[e]; w1[4 + e] = b1[e]; w2[e] = c0[e]; w2[4 + e] = c1[e]; w3[e] = d0[e]; w3[4 + e] = d1[e]; cbv[e] = e0[e]; cbv[4 + e] = e1[e]; } }
  const bf16_t* src = PROJ + (size_t)g0 * LDP + C_XBC + col0;
  float xm3[8], xm2[8], xm1[8];
#pragma unroll
  for (int e = 0; e < 8; ++e) { xm3[e] = 0.f; xm2[e] = 0.f; xm1[e] = 0.f; }
  if (t0 > 0) { unpack8(*(const u32x4*)(src - 3 * LDP), xm3); unpack8(*(const u32x4*)(src - 2 * LDP), xm2); unpack8(*(const u32x4*)(src - 1 * LDP), xm1); }
  const int h = col0 >> 6;
  float dtb = 0.f; if (cb == 0) dtb = p.dt_bias[layer * 8 + h];
  unsigned outp[8][4];
#pragma unroll
  for (int i = 0; i < 8; ++i) {
    float x0[8]; unpack8(*(const u32x4*)(src + (size_t)i * LDP), x0);
    float dt = 1.f;
    if (cb == 0) dt = softplus_f(bf2f(PROJ[(size_t)(g0 + i) * LDP + C_DT + h]) + dtb);
    float v[8];
#pragma unroll
    for (int e = 0; e < 8; ++e) { v[e] = silu_f(w0[e] * xm3[e] + w1[e] * xm2[e] + w2[e] * xm1[e] + w3[e] * x0[e] + cbv[e]); xm3[e] = xm2[e]; xm2[e] = xm1[e]; xm1[e] = x0[e]; }
    u32x4 o; o.x = pk2(v[0], v[1]); o.y = pk2(v[2], v[3]); o.z = pk2(v[4], v[5]); o.w = pk2(v[6], v[7]);
    *(u32x4*)(XC + (size_t)(g0 + i) * 1024 + col0) = o;
#pragma unroll
    for (int e = 0; e < 8; ++e) { const unsigned q = f2bf(v[e] * dt); if (i & 1) outp[e][i >> 1] |= (q << 16); else outp[e][i >> 1] = q; }
  }
  bf16_t* dst = nullptr;
  if (cb == 0) dst = (bf16_t*)(p.ws + WS_XDT) + ((size_t)(b * 8 + h) * 64 + (col0 & 63)) * SEQ + t0;
  else if (lane < 32) dst = (bf16_t*)(p.ws + WS_BT) + ((size_t)(b * 2 + (lane >> 4)) * 128 + ((lane * 8) & 127)) * SEQ + t0;
  if (dst) {
#pragma unroll
    for (int e = 0; e < 8; ++e) {
      u32x4 o0; o0.x = outp[e][0]; o0.y = outp[e][1]; o0.z = outp[e][2]; o0.w = outp[e][3];
      *(u32x4*)(dst + (size_t)e * SEQ) = o0; }
  }
}
template <int NR>
__device__ __forceinline__ void vtrans_tile(const P& p, int g0, int cbase, int c0, int nh, bf16_t* VT) {
  const bf16_t* PROJ = (const bf16_t*)(p.ws + WS_PROJ);
  const int b = g0 >> 12, t0 = g0 & (SEQ - 1);
  const bf16_t* src = PROJ + (size_t)g0 * LDP + cbase + c0;
  unsigned outp[8][NR / 2];
#pragma unroll
  for (int i = 0; i < NR; ++i) { const u32x4 v = *(const u32x4*)(src + (size_t)i * LDP);
    const unsigned q[8] = {v.x & 0xffffu, v.x >> 16, v.y & 0xffffu, v.y >> 16, v.z & 0xffffu, v.z >> 16, v.w & 0xffffu, v.w >> 16};
#pragma unroll
    for (int e = 0; e < 8; ++e) { if (i & 1) outp[e][i >> 1] |= (q[e] << 16); else outp[e][i >> 1] = q[e]; } }
  bf16_t* dst = VT + ((size_t)(b * nh + (c0 >> 6)) * 64 + (c0 & 63)) * SEQ + t0;
#pragma unroll
  for (int e = 0; e < 8; ++e)
#pragma unroll
    for (int j = 0; j < NR / 8; ++j) { u32x4 o; o.x = outp[e][4 * j]; o.y = outp[e][4 * j + 1]; o.z = outp[e][4 * j + 2]; o.w = outp[e][4 * j + 3]; *(u32x4*)(dst + (size_t)e * SEQ + 8 * j) = o; }
}
__device__ __forceinline__ void dtscan_unit(const P& p, int layer, int u, int lane, int wave  ) {
  const bf16_t* PROJ = (const bf16_t*)(p.ws + WS_PROJ);
  const int b = u >> 4, c = u & 15, h = wave;
  const float dtb = p.dt_bias[layer * 8 + h], A = -expf(p.a_log[layer * 8 + h]);
  const int t = c * 256 + 4 * lane;
  float dt[4], a[4];
#pragma unroll
  for (int i = 0; i < 4; ++i) { dt[i] = softplus_f(bf2f(PROJ[(size_t)(b * SEQ + t + i) * LDP + C_DT + h]) + dtb); a[i] = dt[i] * A; }
  a[1] += a[0]; a[2] += a[1]; a[3] += a[2];
  float incl = a[3];
#pragma unroll
  for (int o = 1; o < 64; o <<= 1) { const float v = __shfl_up(incl, o); if (lane >= o) incl += v; }
  const float excl = incl - a[3];
  float* DTV = (float*)(p.ws + WS_DTV) + (size_t)(b * 8 + h) * SEQ + t; float* AC = (float*)(p.ws + WS_ACUM) + (size_t)(b * 8 + h) * SEQ + t;
  *(f32x4*)DTV = (f32x4){dt[0], dt[1], dt[2], dt[3]};
  *(f32x4*)AC = (f32x4){a[0] + excl, a[1] + excl, a[2] + excl, a[3] + excl};
}
__device__ __forceinline__ void kmean_unit(const P& p, int u, int tid, int lane, int wv, LAS unsigned char* lds) {
  const bf16_t* PROJ = (const bf16_t*)(p.ws + WS_PROJ);
  const int b = u >> 4, blk = u & 15;
  const bf16_t* src = PROJ + (size_t)(b * SEQ + blk * 256 + wv * 32) * LDP + C_MK + lane * 8;
  float s[8];
#pragma unroll
  for (int e = 0; e < 8; ++e) s[e] = 0.f;
#pragma unroll
  for (int i = 0; i < 32; ++i) { const u32x4 v = *(const u32x4*)(src + (size_t)i * LDP);
    s[0] += bflo(v.x); s[1] += bfhi(v.x); s[2] += bflo(v.y); s[3] += bfhi(v.y); s[4] += bflo(v.z); s[5] += bfhi(v.z); s[6] += bflo(v.w); s[7] += bfhi(v.w); }
  LAS float* red = (LAS float*)lds;
#pragma unroll
  for (int e = 0; e < 8; ++e) red[wv * 512 + lane * 8 + e] = s[e];
  __syncthreads();
  float t = 0.f;
#pragma unroll
  for (int w = 0; w < 8; ++w) t += red[w * 512 + tid];
  float* KM = (float*)(p.ws + WS_KMEAN);
  KM[((size_t)(b * 8 + (tid >> 6)) * 16 + blk) * 64 + (tid & 63)] = t * (1.f / 256.f);
  __syncthreads();
}

constexpr int S5_XP = 136;
struct S5C { float ar[2], ai[2], pwr[2][4], pwi[2][4]; bf16x8 Bf[4]; };
__device__ __forceinline__ void s5w_setup(const P& p, int layer, int g, int r, int hf, S5C& S) {
#pragma unroll
  for (int q = 0; q < 2; ++q) {
    const int gp = (layer * 32 + g) * 64 + q * 32 + r;
    const float lr = p.a_re[gp], li = p.a_im[gp], step = expf(p.log_dt[layer * 32 + g]);
    const float xr = lr * step, xi = li * step;
    const float er = expf(xr), em1 = expm1f(xr); float sn, cs; sincosf(xi, &sn, &cs);
    const float ar = er * cs, ai = er * sn;
    S.ar[q] = ar; S.ai[q] = ai;
    const float sh = sinf(0.5f * xi);
    const float nr = em1 * cs - 2.f * sh * sh, ni = ai;
    const float den = 1.f / (lr * lr + li * li);
    const float cr = (nr * lr + ni * li) * den, ci = (ni * lr - nr * li) * den;
    const float* br = p.b_re + (size_t)gp * 16 + 8 * hf; const float* bi = p.b_im + (size_t)gp * 16 + 8 * hf;
    const f32x4 r0 = *(const f32x4*)br, r1 = *(const f32x4*)(br + 4), i0 = *(const f32x4*)bi, i1 = *(const f32x4*)(bi + 4);
    union { bf16x8 v; unsigned w[4]; } fr, fi;
    fr.w[0] = pk2(cr * r0[0] - ci * i0[0], cr * r0[1] - ci * i0[1]); fr.w[1] = pk2(cr * r0[2] - ci * i0[2], cr * r0[3] - ci * i0[3]);
    fr.w[2] = pk2(cr * r1[0] - ci * i1[0], cr * r1[1] - ci * i1[1]); fr.w[3] = pk2(cr * r1[2] - ci * i1[2], cr * r1[3] - ci * i1[3]);
    fi.w[0] = pk2(cr * i0[0] + ci * r0[0], cr * i0[1] + ci * r0[1]); fi.w[1] = pk2(cr * i0[2] + ci * r0[2], cr * i0[3] + ci * r0[3]);
    fi.w[2] = pk2(cr * i1[0] + ci * r1[0], cr * i1[1] + ci * r1[1]); fi.w[3] = pk2(cr * i1[2] + ci * r1[2], cr * i1[3] + ci * r1[3]);
    S.Bf[2 * q] = fr.v; S.Bf[2 * q + 1] = fi.v;
    float pr = ar, pi = ai;
#pragma unroll
    for (int i = 0; i < 4; ++i) { S.pwr[q][i] = pr; S.pwi[q][i] = pi; const float n0 = pr * ar - pi * ai, n1 = pr * ai + pi * ar; pr = n0; pi = n1; }
  }
}
template <bool APPLY>
__device__ __forceinline__ void s5w_scan_tile(const S5C& S, const bf16x8 uf, f32x16 (&acc)[4], float (&cin)[2][2], int hf) {
#pragma unroll
  for (int kt = 0; kt < 4; ++kt) {
#pragma unroll
    for (int i = 0; i < 16; ++i) acc[kt][i] = 0.f;
    acc[kt] = MFMA32(uf, S.Bf[kt], acc[kt]);
  }
  float cgr[2][4], cgi[2][4];
#pragma unroll
  for (int q = 0; q < 2; ++q) {
    const float ar = S.ar[q], ai = S.ai[q];
#pragma unroll
    for (int G = 0; G < 4; ++G)
#pragma unroll
      for (int i = 1; i < 4; ++i) { const int k = 4 * G + i;
        const float xr = acc[2 * q][k - 1], xi = acc[2 * q + 1][k - 1];
        acc[2 * q][k] += ar * xr - ai * xi; acc[2 * q + 1][k] += ar * xi + ai * xr; }
  }
#pragma unroll
  for (int s = 0; s < 8; ++s) {
    const int G = s >> 1; const bool act = (hf == (s & 1));
#pragma unroll
    for (int q = 0; q < 2; ++q) {
      const float er = acc[2 * q][4 * G + 3] + S.pwr[q][3] * cin[q][0] - S.pwi[q][3] * cin[q][1];
      const float ei = acc[2 * q + 1][4 * G + 3] + S.pwr[q][3] * cin[q][1] + S.pwi[q][3] * cin[q][0];
      const float rr = __shfl_xor(er, 32), ri = __shfl_xor(ei, 32);
      if (s & 1) { if (hf) { cgr[q][G] = cin[q][0]; cgi[q][G] = cin[q][1]; } }
      else       { if (!hf) { cgr[q][G] = cin[q][0]; cgi[q][G] = cin[q][1]; } }
      cin[q][0] = act ? cin[q][0] : rr; cin[q][1] = act ? cin[q][1] : ri;
    }
  }
  if (APPLY) {
#pragma unroll
    for (int q = 0; q < 2; ++q)
#pragma unroll
      for (int G = 0; G < 4; ++G)
#pragma unroll
        for (int i = 0; i < 4; ++i) { const int k = 4 * G + i;
          acc[2 * q][k] += S.pwr[q][i] * cgr[q][G] - S.pwi[q][i] * cgi[q][G];
          acc[2 * q + 1][k] += S.pwr[q][i] * cgi[q][G] + S.pwi[q][i] * cgr[q][G]; }
  }
}
constexpr int S5_NCH = SEQ / 256;
__device__ __forceinline__ void s5_m1_task(const P& p, int layer, int task, int lane) {
  const bf16_t* PROJ = (const bf16_t*)(p.ws + WS_PROJ);
  const int g = task & 31, c = (task >> 5) & 15, b = task >> 9, r = lane & 31, hf = lane >> 5;
  S5C S; s5w_setup(p, layer, g, r, hf, S);
  float cin[2][2] = {{0.f, 0.f}, {0.f, 0.f}};
  const bf16_t* up = PROJ + (size_t)(b * SEQ + c * 256 + r) * LDP + C_SU + g * 16;
  f32x16 acc[4];
  bf16x8 ufc = *(const bf16x8*)(up + 8 * hf);
#pragma unroll 1
  for (int tt = 0; tt < 8; ++tt) {
    const bf16x8 ufn = *(const bf16x8*)(up + (size_t)(tt < 7 ? tt + 1 : tt) * 32 * LDP + 8 * hf);
    s5w_scan_tile<false>(S, ufc, acc, cin, hf);
    ufc = ufn;
  }
  if (hf == 0) {
    float* E = (float*)(p.ws + WS_S5E) + ((size_t)((b * 32 + g) * 16 + c) * 64 + r) * 2;
    *(float2*)E = make_float2(cin[0][0], cin[0][1]);
    *(float2*)(E + 64) = make_float2(cin[1][0], cin[1][1]);
  }
}
__device__ __forceinline__ void s5_m2_task(const P& p, int layer, int task_s, int task, int lane, LAS bf16_t* Xl) {
  const bf16_t* PROJ = (const bf16_t*)(p.ws + WS_PROJ); bf16_t* S5Y = (bf16_t*)(p.ws + WS_S5Y);
  const int g = task & 31, c = (task >> 5) & 15, b = task >> 9, r = lane & 31, hf = lane >> 5; const int c_s = (task_s >> 5) & 15;
  S5C S; s5w_setup(p, layer, g, r, hf, S);
  LAS bf16_t* Afl = Xl + 32 * S5_XP;
#pragma unroll
  for (int ks = 0; ks < 8; ++ks) {
    const int k0 = 16 * ks + 8 * hf, kt = k0 >> 5, rr = k0 & 31, p0 = (kt >> 1) * 32 + rr;
    if (r < 16) {
      const float* src = ((kt & 1) ? p.c_im : p.c_re) + ((size_t)(layer * 32 + g) * 16 + r) * 64 + p0;
      const f32x4 v0 = *(const f32x4*)src, v1 = *(const f32x4*)(src + 4); const float sg = (kt & 1) ? -1.f : 1.f;
      u32x4 f; f.x = pk2(sg * v0[0], sg * v0[1]); f.y = pk2(sg * v0[2], sg * v0[3]); f.z = pk2(sg * v1[0], sg * v1[1]); f.w = pk2(sg * v1[2], sg * v1[3]);
      *(LAS u32x4*)(Afl + (ks * 32 + r * 2 + hf) * 8) = f;
    }
  }
  asm volatile("s_waitcnt lgkmcnt(0)" ::: "memory");
  const f32x4 dsk0 = *(const f32x4*)(p.s5_d + layer * 512 + g * 16 + 4 * hf), dsk1 = *(const f32x4*)(p.s5_d + layer * 512 + g * 16 + 8 + 4 * hf);
  float cin[2][2];
#pragma unroll
  for (int q = 0; q < 2; ++q) {
    float pr = S.pwr[q][3], pi = S.pwi[q][3];
#pragma unroll
    for (int i = 0; i < 6; ++i) { const float n0 = pr * pr - pi * pi, n1 = 2.f * pr * pi; pr = n0; pi = n1; }
    float sr = 0.f, si = 0.f;
    const float* E = (const float*)(p.ws + WS_S5E) + ((size_t)((b * 32 + g) * 16) * 64 + q * 32 + r) * 2;
#pragma unroll 5
    for (int c2 = 0; c2 < c_s; ++c2) { const float2 e = *(const float2*)(E + (size_t)c2 * 128);
      const float n0 = pr * sr - pi * si + e.x, n1 = pr * si + pi * sr + e.y; sr = n0; si = n1; }
    cin[q][0] = sr; cin[q][1] = si;
  }
  const bf16_t* up = PROJ + (size_t)(b * SEQ + c * 256 + r) * LDP + C_SU + g * 16;
  bf16_t* yp = S5Y + (size_t)(b * SEQ + c * 256 + r) * S5YP + g * 16;
  bf16_t* mixp = (bf16_t*)(p.ws + WS_MIX) + (size_t)(b * SEQ + c * 256 + r) * MIXW + 1536 + g * 16;
  f32x16 acc[4];
  bf16x8 ufc = *(const bf16x8*)(up + 8 * hf);
#pragma unroll 1
  for (int tt = 0; tt < 8; ++tt) {
    const bf16_t* ur = up + (size_t)tt * 32 * LDP;
    const bf16x8 ufn = *(const bf16x8*)(up + (size_t)(tt < 7 ? tt + 1 : tt) * 32 * LDP + 8 * hf);
    s5w_scan_tile<true>(S, ufc, acc, cin, hf);
    ufc = ufn;
#pragma unroll
    for (int kt = 0; kt < 4; ++kt)
#pragma unroll
      for (int i = 0; i < 16; ++i) Xl[crow(i, hf) * S5_XP + 32 * kt + r] = f2bf(acc[kt][i]);
    asm volatile("s_waitcnt lgkmcnt(0)" ::: "memory");
    f32x16 y;
#pragma unroll
    for (int i = 0; i < 16; ++i) y[i] = 0.f;
#pragma unroll
    for (int ks = 0; ks < 8; ++ks) { const bf16x8 xf = *(const LAS bf16x8*)(Xl + r * S5_XP + 16 * ks + 8 * hf); const bf16x8 af = *(const LAS bf16x8*)(Afl + (ks * 32 + (r & 15) * 2 + hf) * 8); y = MFMA32(af, xf, y); }
    asm volatile("s_waitcnt lgkmcnt(0)" ::: "memory");
    const u32x2 u0 = *(const u32x2*)(ur + 4 * hf), u1 = *(const u32x2*)(ur + 8 + 4 * hf);
    u32x2 w0, w1;
    w0.x = pk2(gelu_tanh_f(y[0] + dsk0[0] * bflo(u0.x)), gelu_tanh_f(y[1] + dsk0[1] * bfhi(u0.x)));
    w0.y = pk2(gelu_tanh_f(y[2] + dsk0[2] * bflo(u0.y)), gelu_tanh_f(y[3] + dsk0[3] * bfhi(u0.y)));
    w1.x = pk2(gelu_tanh_f(y[4] + dsk1[0] * bflo(u1.x)), gelu_tanh_f(y[5] + dsk1[1] * bfhi(u1.x)));
    w1.y = pk2(gelu_tanh_f(y[6] + dsk1[2] * bflo(u1.y)), gelu_tanh_f(y[7] + dsk1[3] * bfhi(u1.y)));
    bf16_t* yr = yp + (size_t)tt * 32 * S5YP;
    *(u32x2*)(yr + 4 * hf) = w0; *(u32x2*)(yr + 8 + 4 * hf) = w1;
    { const u32x2 g0 = *(const u32x2*)(ur + (C_S5G - C_SU) + 4 * hf), g1 = *(const u32x2*)(ur + (C_S5G - C_SU) + 8 + 4 * hf);
      u32x2 m0, m1;
      m0.x = pk2(bflo(w0.x) * silu_f(bflo(g0.x)), bfhi(w0.x) * silu_f(bfhi(g0.x))); m0.y = pk2(bflo(w0.y) * silu_f(bflo(g0.y)), bfhi(w0.y) * silu_f(bfhi(g0.y)));
      m1.x = pk2(bflo(w1.x) * silu_f(bflo(g1.x)), bfhi(w1.x) * silu_f(bfhi(g1.x))); m1.y = pk2(bflo(w1.y) * silu_f(bflo(g1.y)), bfhi(w1.y) * silu_f(bfhi(g1.y)));
      bf16_t* mr = mixp + (size_t)tt * 32 * MIXW;
      *(u32x2*)(mr + 4 * hf) = m0; *(u32x2*)(mr + 8 + 4 * hf) = m1; }
  }
}

struct AttnAcc { f32x16 o0, o1; float m, l; };
template <int MASK>
__device__ __forceinline__ void attn_tile(AttnAcc& a, const bf16x8 (&qf)[4], const bf16_t* krow, const bf16_t* vt, int r, int hf, bool dead_col) {
  f32x16 s;
#pragma unroll
  for (int i = 0; i < 16; ++i) s[i] = 0.f;
#pragma unroll
  for (int ks = 0; ks < 4; ++ks) { const bf16x8 kf = *(const bf16x8*)(krow + 16 * ks); s = MFMA32(kf, qf[ks], s); }
  float mloc = -INFINITY;
#pragma unroll
  for (int i = 0; i < 16; ++i) {
    const int row = crow(i, hf);
    bool dead = dead_col;
    if (MASK == 1) dead = dead || (row > r);
    if (MASK == 2) dead = dead || (row <= r);
    s[i] = dead ? -INFINITY : s[i];
    mloc = fmaxf(mloc, s[i]);
  }
  mloc = fmaxf(mloc, __shfl_xor(mloc, 32));
  const float mnew = fmaxf(a.m, mloc);
  const float alpha = fexp2(a.m - mnew);
  float ls = 0.f;
#pragma unroll
  for (int i = 0; i < 16; ++i) { s[i] = fexp2(s[i] - mnew); ls += s[i]; }
  a.l = a.l * alpha + ls; a.m = mnew;
#pragma unroll
  for (int i = 0; i < 16; ++i) { a.o0[i] *= alpha; a.o1[i] *= alpha; }
  union { bf16x8 v; unsigned w[4]; } p0, p1;
#pragma unroll
  for (int i = 0; i < 4; ++i) { p0.w[i] = pk2(s[2 * i], s[2 * i + 1]); p1.w[i] = pk2(s[8 + 2 * i], s[8 + 2 * i + 1]); }
#pragma unroll
  for (int mb = 0; mb < 2; ++mb) {
    const bf16_t* vp = vt + (size_t)mb * 32 * SEQ;
    union { bf16x8 v; bf16x4 h[2]; } va, vb;
    va.h[0] = *(const bf16x4*)(vp); va.h[1] = *(const bf16x4*)(vp + 8);
    vb.h[0] = *(const bf16x4*)(vp + 16); vb.h[1] = *(const bf16x4*)(vp + 24);
    if (mb == 0) { a.o0 = MFMA32(va.v, p0.v, a.o0); a.o0 = MFMA32(vb.v, p1.v, a.o0); }
    else { a.o1 = MFMA32(va.v, p0.v, a.o1); a.o1 = MFMA32(vb.v, p1.v, a.o1); }
  }
}
__device__ __forceinline__ void attn_store(const AttnAcc& a, float ltot, const bf16_t* gaterow, bf16_t* outrow, int hf) {
  const float inv = 1.f / ltot;
#pragma unroll
  for (int mb = 0; mb < 2; ++mb)
#pragma unroll
    for (int q4 = 0; q4 < 4; ++q4) {
      const int d0 = 8 * q4 + 4 * hf + 32 * mb;
      const u32x2 gv = *(const u32x2*)(gaterow + d0);
      float o[4];
#pragma unroll
      for (int i = 0; i < 4; ++i) o[i] = (mb == 0 ? a.o0[4 * q4 + i] : a.o1[4 * q4 + i]) * inv;
      o[0] *= silu_f(bflo(gv.x)); o[1] *= silu_f(bfhi(gv.x)); o[2] *= silu_f(bflo(gv.y)); o[3] *= silu_f(bfhi(gv.y));
      u32x2 w; w.x = pk2(o[0], o[1]); w.y = pk2(o[2], o[3]);
      *(u32x2*)(outrow + d0) = w;
    }
}

constexpr int MB_KP = 72, MB_VP = 260, MB_KBYTES = 256 * MB_KP * 2, MB_VBYTES = 64 * MB_VP * 2, MB_BUF = MB_KBYTES + MB_VBYTES;
struct MobaStage { u32x4 k[4], v[4]; };
__device__ __forceinline__ void moba_stage_load(MobaStage& st, const bf16_t* kg, const bf16_t* vg, int tid) {
#pragma unroll
  for (int i = 0; i < 4; ++i) { const int idx = tid + 512 * i;
    st.k[i] = *(const u32x4*)(kg + (size_t)(idx >> 3) * LDP + (idx & 7) * 8);
    st.v[i] = *(const u32x4*)(vg + (size_t)(idx >> 5) * SEQ + (idx & 31) * 8); }
}
__device__ __forceinline__ void moba_stage_store(const MobaStage& st, LAS unsigned char* buf, int tid) {
#pragma unroll
  for (int i = 0; i < 4; ++i) { const int idx = tid + 512 * i;
    *(LAS u32x4*)(buf + ((idx >> 3) * MB_KP + (idx & 7) * 8) * 2) = st.k[i];
    LAS unsigned char* vp = buf + MB_KBYTES + ((idx >> 5) * MB_VP + (idx & 31) * 8) * 2;
    *(LAS u32x2*)vp = (u32x2){st.v[i].x, st.v[i].y}; *(LAS u32x2*)(vp + 8) = (u32x2){st.v[i].z, st.v[i].w}; }
}
template <int MASK>
__device__ __forceinline__ void attn_tile_lds(AttnAcc& a, const bf16x8 (&qf)[4], const LAS unsigned char* buf, int tile, int r, int hf, bool dead_col) {
  f32x16 s;
#pragma unroll
  for (int i = 0; i < 16; ++i) s[i] = 0.f;
  const LAS bf16_t* kp = (const LAS bf16_t*)buf + (tile * 32 + r) * MB_KP + 8 * hf;
#pragma unroll
  for (int ks = 0; ks < 4; ++ks) { const bf16x8 kf = *(const LAS bf16x8*)(kp + 16 * ks); s = MFMA32(kf, qf[ks], s); }
  float mloc = -INFINITY;
#pragma unroll
  for (int i = 0; i < 16; ++i) {
    if (MASK == 1) { const int row = crow(i, hf); s[i] = (row > r) ? -INFINITY : s[i]; }
    if (MASK == 2) { const int row = crow(i, hf); s[i] = (row <= r) ? -INFINITY : s[i]; }
    mloc = fmaxf(mloc, s[i]);
  }
  mloc = dead_col ? -INFINITY : mloc;
  mloc = fmaxf(mloc, __shfl_xor(mloc, 32));
  const float mnew = fmaxf(a.m, mloc);
  const float alpha = fexp2(a.m - mnew);
  const float msub = dead_col ? INFINITY : mnew;
  float ls = 0.f;
#pragma unroll
  for (int i = 0; i < 16; ++i) { s[i] = fexp2(s[i] - msub); ls += s[i]; }
  a.l = a.l * alpha + ls; a.m = mnew;
  if (__ballot(alpha != 1.f) != 0ull) {
#pragma unroll
    for (int i = 0; i < 16; ++i) { a.o0[i] *= alpha; a.o1[i] *= alpha; }
  }
  union { bf16x8 v; unsigned w[4]; } p0, p1;
#pragma unroll
  for (int i = 0; i < 4; ++i) { p0.w[i] = pk2(s[2 * i], s[2 * i + 1]); p1.w[i] = pk2(s[8 + 2 * i], s[8 + 2 * i + 1]); }
  const LAS bf16_t* vb = (const LAS bf16_t*)(buf + MB_KBYTES) + r * MB_VP + tile * 32 + 4 * hf;
#pragma unroll
  for (int mb = 0; mb < 2; ++mb) {
    const LAS bf16_t* vp = vb + mb * 32 * MB_VP;
    union { bf16x8 v; bf16x4 h[2]; } va, vbb;
    va.h[0] = *(const LAS bf16x4*)(vp); va.h[1] = *(const LAS bf16x4*)(vp + 8);
    vbb.h[0] = *(const LAS bf16x4*)(vp + 16); vbb.h[1] = *(const LAS bf16x4*)(vp + 24);
    if (mb == 0) { a.o0 = MFMA32(va.v, p0.v, a.o0); a.o0 = MFMA32(vbb.v, p1.v, a.o0); }
    else { a.o1 = MFMA32(va.v, p0.v, a.o1); a.o1 = MFMA32(vbb.v, p1.v, a.o1); }
  }
}
__device__ __forceinline__ void attn_tile_lds_frozen(AttnAcc& a, const bf16x8 (&qf)[4], const LAS unsigned char* buf, int tile, int r, int hf, float msub, float& smax) {
  f32x16 s;
#pragma unroll
  for (int i = 0; i < 16; ++i) s[i] = 0.f;
  const LAS bf16_t* kp = (const LAS bf16_t*)buf + (tile * 32 + r) * MB_KP + 8 * hf;
#pragma unroll
  for (int ks = 0; ks < 4; ++ks) { const bf16x8 kf = *(const LAS bf16x8*)(kp + 16 * ks); s = MFMA32(kf, qf[ks], s); }
  float ls = 0.f;
#pragma unroll
  for (int i = 0; i < 16; ++i) { smax = fmaxf(smax, s[i]); s[i] = fexp2(s[i] - msub); ls += s[i]; }
  a.l += ls;
  union { bf16x8 v; unsigned w[4]; } p0, p1;
#pragma unroll
  for (int i = 0; i < 4; ++i) { p0.w[i] = pk2(s[2 * i], s[2 * i + 1]); p1.w[i] = pk2(s[8 + 2 * i], s[8 + 2 * i + 1]); }
  const LAS bf16_t* vb = (const LAS bf16_t*)(buf + MB_KBYTES) + r * MB_VP + tile * 32 + 4 * hf;
#pragma unroll
  for (int mb = 0; mb < 2; ++mb) {
    const LAS bf16_t* vp = vb + mb * 32 * MB_VP;
    union { bf16x8 v; bf16x4 h[2]; } va, vbb;
    va.h[0] = *(const LAS bf16x4*)(vp); va.h[1] = *(const LAS bf16x4*)(vp + 8);
    vbb.h[0] = *(const LAS bf16x4*)(vp + 16); vbb.h[1] = *(const LAS bf16x4*)(vp + 24);
    if (mb == 0) { a.o0 = MFMA32(va.v, p0.v, a.o0); a.o0 = MFMA32(vbb.v, p1.v, a.o0); }
    else { a.o1 = MFMA32(va.v, p0.v, a.o1); a.o1 = MFMA32(vbb.v, p1.v, a.o1); }
  }
}
__device__ __forceinline__ void moba_subunit(const P& p, int b, int h, int qb, int wq, int wqv, int lane, int tid, LAS unsigned char* lds) {
  const bf16_t* PROJ = (const bf16_t*)(p.ws + WS_PROJ); bf16_t* MIX = (bf16_t*)(p.ws + WS_MIX);
  const bf16_t* kg0 = PROJ + (size_t)b * SEQ * LDP + C_MK + h * 64;
  const bf16_t* vg0 = (const bf16_t*)(p.ws + WS_MVT) + (size_t)(b * 8 + h) * 64 * SEQ;
  const int r = lane & 31, hf = lane >> 5, q0 = qb * 256 + wqv * 32;
  const size_t rowq = (size_t)b * SEQ + q0 + r;
  MobaStage st;
  moba_stage_load(st, kg0 + (size_t)qb * 256 * LDP, vg0 + qb * 256, tid);
  bf16x8 qf[4];
#pragma unroll
  for (int ks = 0; ks < 4; ++ks) qf[ks] = *(const bf16x8*)(PROJ + rowq * LDP + C_MQ + h * 64 + 16 * ks + 8 * hf);
  unsigned sel = 0;
  if (qb > 0) {
    float v1 = -INFINITY, v2 = -INFINITY, v3 = -INFINITY; int i1 = 31, i2 = 31, i3 = 31;
    const float* km = (const float*)(p.ws + WS_KMEAN) + (size_t)(b * 8 + h) * 16 * 64 + 8 * hf;
#pragma unroll
    for (int j = 0; j < 15; ++j) {
      if (j < qb) {
        float g = 0.f;
#pragma unroll
        for (int ks = 0; ks < 4; ++ks) {
          const f32x4 k0 = *(const f32x4*)(km + j * 64 + 16 * ks), k1 = *(const f32x4*)(km + j * 64 + 16 * ks + 4);
          g += bf2f((unsigned short)qf[ks][0]) * k0[0] + bf2f((unsigned short)qf[ks][1]) * k0[1] + bf2f((unsigned short)qf[ks][2]) * k0[2] + bf2f((unsigned short)qf[ks][3]) * k0[3];
          g += bf2f((unsigned short)qf[ks][4]) * k1[0] + bf2f((unsigned short)qf[ks][5]) * k1[1] + bf2f((unsigned short)qf[ks][6]) * k1[2] + bf2f((unsigned short)qf[ks][7]) * k1[3];
        }
        g += __shfl_xor(g, 32);
        if (g > v1) { v3 = v2; i3 = i2; v2 = v1; i2 = i1; v1 = g; i1 = j; }
        else if (g > v2) { v3 = v2; i3 = i2; v2 = g; i2 = j; }
        else if (g > v3) { v3 = g; i3 = j; }
      }
    }
    sel = ((1u << i1) | (1u << i2) | (1u << i3)) & ((1u << qb) - 1u);
  }
  AttnAcc a;
#pragma unroll
  for (int i = 0; i < 16; ++i) { a.o0[i] = 0.f; a.o1[i] = 0.f; }
  a.m = -INFINITY; a.l = 0.f;
  moba_stage_store(st, lds, tid);
  __syncthreads();
  const int nblk = qb + 1;
#pragma unroll 1
  for (int it = 0; it < nblk; ++it) {
    const bool more = it + 1 < nblk;
    if (more) moba_stage_load(st, kg0 + (size_t)it * 256 * LDP, vg0 + it * 256, tid);
    const LAS unsigned char* buf = lds + (it & 1) * MB_BUF;
    if (it == 0) {
      attn_tile_lds<1>(a, qf, buf, wqv, r, hf, false);
      for (int i = 0; i < wq; ++i) attn_tile_lds<0>(a, qf, buf, i, r, hf, false);
    } else {
      const bool on = (sel >> (it - 1)) & 1u;
      if (__ballot(on) != 0ull) {
        const float msub = on ? a.m : INFINITY;
        float smax = -INFINITY;
#pragma unroll 2
        for (int t = 0; t < 8; ++t) attn_tile_lds_frozen(a, qf, buf, t, r, hf, msub, smax);
        smax = on ? smax : -INFINITY;
        smax = fmaxf(smax, __shfl_xor(smax, 32));
        const float mnew = fmaxf(a.m, smax), alpha = fexp2(a.m - mnew);
        a.m = mnew;
        if (__ballot(alpha != 1.f) != 0ull) {
          a.l *= alpha;
#pragma unroll
          for (int i = 0; i < 16; ++i) { a.o0[i] *= alpha; a.o1[i] *= alpha; }
        }
      }
    }
    if (more) moba_stage_store(st, lds + ((it + 1) & 1) * MB_BUF, tid);
    __syncthreads();
  }
  const float ltot = a.l + __shfl_xor(a.l, 32);
  attn_store(a, ltot, PROJ + rowq * LDP + C_MG + h * 64, MIX + rowq * MIXW + h * 64, hf);
}

__device__ __forceinline__ void swa_unit(const P& p, int layer, int b, int kvh, int Q, int wq, int wqv, int lane, int tid, LAS unsigned char* lds) {
  const bf16_t* PROJ = (const bf16_t*)(p.ws + WS_PROJ); bf16_t* MIX = (bf16_t*)(p.ws + WS_MIX);
  const bf16_t* kg0 = PROJ + (size_t)b * SEQ * LDP + C_SK + kvh * 64;
  const bf16_t* vg0 = (const bf16_t*)(p.ws + WS_SVT) + (size_t)(b * 2 + kvh) * 64 * SEQ;
  const int r = lane & 31, hf = lane >> 5, q0 = Q * 256 + wqv * 32;
  const size_t rowq = (size_t)b * SEQ + q0 + r;
  { MobaStage st;
    if (Q > 0) { moba_stage_load(st, kg0 + (size_t)(Q - 1) * 256 * LDP, vg0 + (Q - 1) * 256, tid); moba_stage_store(st, lds, tid); }
    moba_stage_load(st, kg0 + (size_t)Q * 256 * LDP, vg0 + Q * 256, tid); moba_stage_store(st, lds + MB_BUF, tid); }
  __syncthreads();
  const LAS unsigned char* bprev = lds; const LAS unsigned char* bown = lds + MB_BUF;
#pragma unroll 1
  for (int hh = 0; hh < 4; ++hh) {
    const int hq = kvh * 4 + hh;
    bf16x8 qf[4];
#pragma unroll
    for (int ks = 0; ks < 4; ++ks) qf[ks] = *(const bf16x8*)(PROJ + rowq * LDP + C_SQ + hq * 64 + 16 * ks + 8 * hf);
    AttnAcc a;
#pragma unroll
    for (int i = 0; i < 16; ++i) { a.o0[i] = 0.f; a.o1[i] = 0.f; }
    a.m = -INFINITY; a.l = 0.f;
    attn_tile_lds<1>(a, qf, bown, wqv, r, hf, false);
#pragma unroll
    for (int d = 1; d <= 3; ++d) {
      if (wq - d >= 0) attn_tile_lds<0>(a, qf, bown, wqv - d, r, hf, false);
      else if (Q > 0) attn_tile_lds<0>(a, qf, bprev, 8 + wqv - d, r, hf, false);
    }
    if (wq - 4 >= 0) attn_tile_lds<2>(a, qf, bown, wqv - 4, r, hf, false);
    else if (Q > 0) attn_tile_lds<2>(a, qf, bprev, 4 + wqv, r, hf, false);
    float ltot = a.l + __shfl_xor(a.l, 32);
    ltot += fexp2(p.sinks[layer * 8 + hq] * LOG2E - a.m);
    attn_store(a, ltot, PROJ + rowq * LDP + C_SG + hq * 64, MIX + rowq * MIXW + 1024 + hq * 64, hf);
  }
  __syncthreads();
}

__device__ __forceinline__ void swa_task(const P& p, int layer, int b, int hq, int qt_s, int qt, int lane) {
  const bf16_t* PROJ = (const bf16_t*)(p.ws + WS_PROJ); bf16_t* MIX = (bf16_t*)(p.ws + WS_MIX);
  const int kvh = hq >> 2;
  const bf16_t* VT = (const bf16_t*)(p.ws + WS_SVT) + (size_t)(b * 2 + kvh) * 64 * SEQ;
  const int r = lane & 31, hf = lane >> 5, q0 = qt * 32;
  const size_t rowq = (size_t)b * SEQ + q0 + r;
  const int nt = qt_s < 4 ? qt_s : 4;
  bf16x8 qa[4], qb[4];
#pragma unroll
  for (int ks = 0; ks < 4; ++ks) { qa[ks] = *(const bf16x8*)(PROJ + rowq * LDP + C_SQ + hq * 64 + 16 * ks + 8 * hf); qb[ks] = *(const bf16x8*)(PROJ + rowq * LDP + C_SQ + (hq + 1) * 64 + 16 * ks + 8 * hf); }
  AttnAcc a0, a1;
#pragma unroll
  for (int i = 0; i < 16; ++i) { a0.o0[i] = 0.f; a0.o1[i] = 0.f; a1.o0[i] = 0.f; a1.o1[i] = 0.f; }
  a0.m = -INFINITY; a0.l = 0.f; a1.m = -INFINITY; a1.l = 0.f;
  const bf16_t* kbase = PROJ + ((size_t)b * SEQ + r) * LDP + C_SK + kvh * 64 + 8 * hf;
  const bf16_t* vbase = VT + (size_t)r * SEQ + 4 * hf;
  attn_tile<1>(a0, qa, kbase + (size_t)q0 * LDP, vbase + q0, r, hf, false); attn_tile<1>(a1, qb, kbase + (size_t)q0 * LDP, vbase + q0, r, hf, false);
  for (int d = 1; d <= 3; ++d) if (nt >= d) { attn_tile<0>(a0, qa, kbase + (size_t)(q0 - 32 * d) * LDP, vbase + q0 - 32 * d, r, hf, false); attn_tile<0>(a1, qb, kbase + (size_t)(q0 - 32 * d) * LDP, vbase + q0 - 32 * d, r, hf, false); }
  if (nt >= 4) { attn_tile<2>(a0, qa, kbase + (size_t)(q0 - 128) * LDP, vbase + q0 - 128, r, hf, false); attn_tile<2>(a1, qb, kbase + (size_t)(q0 - 128) * LDP, vbase + q0 - 128, r, hf, false); }
  float lt0 = a0.l + __shfl_xor(a0.l, 32), lt1 = a1.l + __shfl_xor(a1.l, 32);
  lt0 += fexp2(p.sinks[layer * 8 + hq] * LOG2E - a0.m); lt1 += fexp2(p.sinks[layer * 8 + hq + 1] * LOG2E - a1.m);
  attn_store(a0, lt0, PROJ + rowq * LDP + C_SG + hq * 64, MIX + rowq * MIXW + 1024 + hq * 64, hf);
  attn_store(a1, lt1, PROJ + rowq * LDP + C_SG + (hq + 1) * 64, MIX + rowq * MIXW + 1024 + (hq + 1) * 64, hf);
}

__device__ __forceinline__ void ssd_state_unit(const P& p, int u, int lane, int wave, int tid, LAS unsigned char* lds) {
  const int h = u & 7, b = u >> 3, g = h >> 2;
  const int r = lane & 31, hf = lane >> 5, nt = wave & 3, pt = wave >> 2;
  LAS float* dl = (LAS float*)lds; LAS float* de = dl + 15 * 256;
  const float* acb = (const float*)(p.ws + WS_ACUM) + (size_t)(b * 8 + h) * SEQ;
  __syncthreads();
  for (int i = tid; i < 15 * 256; i += 512) dl[i] = fexp(acb[(i & ~255) + 255] - acb[i]);
  if (tid < 15) de[tid] = fexp(acb[tid * 256 + 255]);
  __syncthreads();
  f32x16 st;
#pragma unroll
  for (int i = 0; i < 16; ++i) st[i] = 0.f;
#pragma unroll 1
  for (int c = 0; c < 15; ++c) {
    const bf16_t* xrow = (const bf16_t*)(p.ws + WS_XDT) + ((size_t)(b * 8 + h) * 64 + pt * 32 + r) * SEQ + c * 256 + 8 * hf;
    const bf16_t* brow = (const bf16_t*)(p.ws + WS_BT) + ((size_t)(b * 2 + g) * 128 + nt * 32 + r) * SEQ + c * 256 + 8 * hf;
    const LAS float* dc = dl + c * 256 + 8 * hf;
    f32x16 acc;
#pragma unroll
    for (int i = 0; i < 16; ++i) acc[i] = 0.f;
#pragma unroll
    for (int ks = 0; ks < 16; ++ks) {
      const u32x4 xa = *(const u32x4*)(xrow + 16 * ks);
      const f32x4 d0 = *(const LAS f32x4*)(dc + 16 * ks), d1 = *(const LAS f32x4*)(dc + 16 * ks + 4);
      union { bf16x8 v; unsigned w[4]; } xs;
      xs.w[0] = pk2(bflo(xa.x) * d0[0], bfhi(xa.x) * d0[1]);
      xs.w[1] = pk2(bflo(xa.y) * d0[2], bfhi(xa.y) * d0[3]);
      xs.w[2] = pk2(bflo(xa.z) * d1[0], bfhi(xa.z) * d1[1]);
      xs.w[3] = pk2(bflo(xa.w) * d1[2], bfhi(xa.w) * d1[3]);
      const bf16x8 bb = *(const bf16x8*)(brow + 16 * ks);
      acc = MFMA32(xs.v, bb, acc);
    }
    const float dec = de[c];
    bf16_t* SP = (bf16_t*)(p.ws + WS_CS) + (size_t)((b * 16 + c + 1) * 8 + h) * 8192;
#pragma unroll
    for (int i = 0; i < 16; ++i) { st[i] = st[i] * dec + acc[i]; SP[(pt * 32 + crow(i, hf)) * 128 + nt * 32 + r] = f2bf(st[i]); }
  }
}

constexpr int SP_PITCH = 136;
__device__ __forceinline__ void ssd_out_unit(const P& p, int layer, int u, LAS unsigned char* lds, int tid, int lane, int wave, int wv) {
  const int half = u & 1, g = (u >> 1) & 1, c = (u >> 2) & 15, b = u >> 6;
  const bf16_t* PROJ = (const bf16_t*)(p.ws + WS_PROJ); const bf16_t* XC = (const bf16_t*)(p.ws + WS_XC); bf16_t* MIX = (bf16_t*)(p.ws + WS_MIX);
  const float* ACUM = (const float*)(p.ws + WS_ACUM);
  LAS float* ssx = (LAS float*)lds;
  const bf16_t* SPREV = (const bf16_t*)(p.ws + WS_CS);
  const int r = lane & 31, hf = lane >> 5, lt = (wave & 3) + 4 * half, hp = wv >> 2;
  const int l = ((wv & 3) + 4 * half) * 32 + r; const size_t rowl = (size_t)b * SEQ + c * 256 + l;
  bf16x8 Cf[8];
#pragma unroll
  for (int ks = 0; ks < 8; ++ks) Cf[ks] = *(const bf16x8*)(XC + rowl * 1024 + 768 + g * 128 + 16 * ks + 8 * hf);
  f32x16 o[2][2]; float acl[2];
#pragma unroll
  for (int e = 0; e < 2; ++e) {
    const int hh = 2 * hp + e, h = 4 * g + hh;
    acl[e] = ACUM[(size_t)(b * 8 + h) * SEQ + c * 256 + l];
    const float sc = fexp(acl[e]);
#pragma unroll
    for (int mb = 0; mb < 2; ++mb) {
      f32x16 t;
#pragma unroll
      for (int i = 0; i < 16; ++i) t[i] = 0.f;
      if (c > 0) {
        const bf16_t* sp = SPREV + (size_t)((b * 16 + c) * 8 + h) * 8192 + (mb * 32 + r) * 128 + 8 * hf;
#pragma unroll
        for (int ks = 0; ks < 8; ++ks) { const bf16x8 A = *(const bf16x8*)(sp + 16 * ks); t = MFMA32(A, Cf[ks], t); }
#pragma unroll
        for (int i = 0; i < 16; ++i) t[i] *= sc;
      }
      o[e][mb] = t;
    }
  }
#pragma unroll 2
  for (int st = 0; st <= lt; ++st) {
    f32x16 G;
#pragma unroll
    for (int i = 0; i < 16; ++i) G[i] = 0.f;
    const bf16_t* bp = XC + ((size_t)b * SEQ + c * 256 + st * 32 + r) * 1024 + 512 + g * 128 + 8 * hf;
#pragma unroll
    for (int ks = 0; ks < 8; ++ks) { const bf16x8 A = *(const bf16x8*)(bp + 16 * ks); G = MFMA32(A, Cf[ks], G); }
#pragma unroll
    for (int e = 0; e < 2; ++e) {
      const int h = 4 * g + 2 * hp + e;
      const float* as = ACUM + (size_t)(b * 8 + h) * SEQ + c * 256 + st * 32 + 4 * hf;
      float pv[16];
#pragma unroll
      for (int q4 = 0; q4 < 4; ++q4) { const f32x4 a4 = *(const f32x4*)(as + 8 * q4);
#pragma unroll
        for (int i = 0; i < 4; ++i) { const int reg = 4 * q4 + i; const float w = G[reg] * fexp(acl[e] - a4[i]);
          pv[reg] = (st < lt || crow(reg, hf) <= r) ? w : 0.f; } }
      union { bf16x8 v; unsigned w[4]; } p0, p1;
#pragma unroll
      for (int i = 0; i < 4; ++i) { p0.w[i] = pk2(pv[2 * i], pv[2 * i + 1]); p1.w[i] = pk2(pv[8 + 2 * i], pv[8 + 2 * i + 1]); }
      const bf16_t* xt = (const bf16_t*)(p.ws + WS_XDT) + ((size_t)(b * 8 + h) * 64 + r) * SEQ + c * 256 + st * 32 + 4 * hf;
#pragma unroll
      for (int mb = 0; mb < 2; ++mb) {
        const bf16_t* vp = xt + (size_t)mb * 32 * SEQ;
        union { bf16x8 v; bf16x4 hh[2]; } va, vb;
        va.hh[0] = *(const bf16x4*)(vp); va.hh[1] = *(const bf16x4*)(vp + 8);
        vb.hh[0] = *(const bf16x4*)(vp + 16); vb.hh[1] = *(const bf16x4*)(vp + 24);
        o[e][mb] = MFMA32(va.v, p0.v, o[e][mb]); o[e][mb] = MFMA32(vb.v, p1.v, o[e][mb]);
      }
    }
  }
  float ssq = 0.f;
#pragma unroll
  for (int e = 0; e < 2; ++e) {
    const int h = 4 * g + 2 * hp + e; const float Dh = p.ssd_d[layer * 8 + h];
#pragma unroll
    for (int mb = 0; mb < 2; ++mb)
#pragma unroll
      for (int q4 = 0; q4 < 4; ++q4) {
        const int p0 = 8 * q4 + 4 * hf + 32 * mb;
        const u32x2 xv = *(const u32x2*)(XC + rowl * 1024 + h * 64 + p0);
        const u32x2 zv = *(const u32x2*)(PROJ + rowl * LDP + C_Z + h * 64 + p0);
        float y0 = (o[e][mb][4 * q4 + 0] + Dh * bflo(xv.x)) * silu_f(bflo(zv.x));
        float y1 = (o[e][mb][4 * q4 + 1] + Dh * bfhi(xv.x)) * silu_f(bfhi(zv.x));
        float y2 = (o[e][mb][4 * q4 + 2] + Dh * bflo(xv.y)) * silu_f(bflo(zv.y));
        float y3 = (o[e][mb][4 * q4 + 3] + Dh * bfhi(xv.y)) * silu_f(bfhi(zv.y));
        o[e][mb][4 * q4 + 0] = y0; o[e][mb][4 * q4 + 1] = y1; o[e][mb][4 * q4 + 2] = y2; o[e][mb][4 * q4 + 3] = y3;
        ssq += y0 * y0 + y1 * y1 + y2 * y2 + y3 * y3;
      }
  }
  ssq += __shfl_xor(ssq, 32);
  if (hf == 0) ssx[wv * 32 + r] = ssq;
  __syncthreads();
  const float tot = ssx[wv * 32 + r] + ssx[(wv ^ 4) * 32 + r];
  const float rstd = 1.f / sqrtf(tot * (1.f / 256.f) + NORM_EPS);
#pragma unroll
  for (int e = 0; e < 2; ++e) {
    const int h = 4 * g + 2 * hp + e;
#pragma unroll
    for (int mb = 0; mb < 2; ++mb)
#pragma unroll
      for (int q4 = 0; q4 < 4; ++q4) {
        const int p0 = 8 * q4 + 4 * hf + 32 * mb;
        const f32x4 nw = *(const f32x4*)(p.ssd_norm + layer * 512 + h * 64 + p0);
        u32x2 w; w.x = pk2(o[e][mb][4 * q4 + 0] * rstd * nw[0], o[e][mb][4 * q4 + 1] * rstd * nw[1]);
        w.y = pk2(o[e][mb][4 * q4 + 2] * rstd * nw[2], o[e][mb][4 * q4 + 3] * rstd * nw[3]);
        *(u32x2*)(MIX + rowl * MIXW + 512 + h * 64 + p0) = w;
      }
  }
  __syncthreads();
}

template <int NR, bool IN_BF, bool OUT_BF>
__device__ __forceinline__ void postnorm_rows(const bf16_t* Y, const void* xin_, void* xout_, const float* pg, const float* ng, bf16_t* H, int m0, int stride, int lane) {
  f32x4 v[NR][8], xx[NR][8]; float ss[NR];
#pragma unroll
  for (int i = 0; i < NR; ++i) { const size_t ro = (size_t)(m0 + i * stride) * DM + 4 * lane; ss[i] = 0.f;
#pragma unroll
    for (int j = 0; j < 8; ++j) { const u32x2 yv = *(const u32x2*)(Y + ro + 256 * j); v[i][j] = (f32x4){bflo(yv.x), bfhi(yv.x), bflo(yv.y), bfhi(yv.y)};
      if (IN_BF) { const u32x2 xv = *(const u32x2*)((const bf16_t*)xin_ + ro + 256 * j); xx[i][j] = (f32x4){bflo(xv.x), bfhi(xv.x), bflo(xv.y), bfhi(xv.y)}; }
      else xx[i][j] = *(const f32x4*)((const float*)xin_ + ro + 256 * j); } }
#pragma unroll
  for (int i = 0; i < NR; ++i) {
#pragma unroll
    for (int j = 0; j < 8; ++j) ss[i] += v[i][j].x * v[i][j].x + v[i][j].y * v[i][j].y + v[i][j].z * v[i][j].z + v[i][j].w * v[i][j].w;
    ss[i] = wave_sum(ss[i]); }
#pragma unroll
  for (int i = 0; i < NR; ++i) {
    const size_t ro = (size_t)(m0 + i * stride) * DM + 4 * lane;
    const float rstd = 1.f / sqrtf(ss[i] * (1.f / DM) + NORM_EPS);
    float s2 = 0.f;
#pragma unroll
    for (int j = 0; j < 8; ++j) { const f32x4 gg = *(const f32x4*)(pg + 4 * lane + 256 * j);
      v[i][j] = xx[i][j] + v[i][j] * rstd * gg;
      if (OUT_BF) { u32x2 o; o.x = pk2(v[i][j].x, v[i][j].y); o.y = pk2(v[i][j].z, v[i][j].w); *(u32x2*)((bf16_t*)xout_ + ro + 256 * j) = o; }
      else *(f32x4*)((float*)xout_ + ro + 256 * j) = v[i][j];
      s2 += v[i][j].x * v[i][j].x + v[i][j].y * v[i][j].y + v[i][j].z * v[i][j].z + v[i][j].w * v[i][j].w; }
    if (ng) {
      const float r2 = 1.f / sqrtf(wave_sum(s2) * (1.f / DM) + NORM_EPS);
#pragma unroll
      for (int j = 0; j < 8; ++j) { const f32x4 gg = *(const f32x4*)(ng + 4 * lane + 256 * j);
        u32x2 o; o.x = pk2(v[i][j].x * r2 * gg.x, v[i][j].y * r2 * gg.y); o.y = pk2(v[i][j].z * r2 * gg.z, v[i][j].w * r2 * gg.w);
        *(u32x2*)(H + ro + 256 * j) = o; }
    }
  }
}

#ifndef RU_MOBA
#define RU_MOBA 1
#endif
#ifndef RU_SWA
#define RU_SWA 1
#endif
#ifndef RU_ST
#define RU_ST 1
#endif
#ifndef RU_S5M2
#define RU_S5M2 1
#endif
#ifndef RU_SSDOUT
#define RU_SSDOUT 1
#endif
#ifndef RU_CONV
#define RU_CONV 1
#endif
#ifndef RU_S5M1
#define RU_S5M1 1
#endif
#ifndef RU_VT
#define RU_VT 1
#endif
namespace xb {
#define XB_TMO      128
#define XB_XCNT(j)  (256  + 64 * (j))
#define XB_XSUB(j)  (1280 + 64 * (j))
#define XB_XGEN(j)  (2304 + 64 * (j))
#define XB_TOP      3328
#define XB_TOPGEN   3392
#define XCD_BAR_WORDS 3456
#define XB_SPIN_CAP (1u << 18)

__device__ __forceinline__ unsigned xb_ld(unsigned* p)              { return __hip_atomic_load(p, __ATOMIC_RELAXED, __HIP_MEMORY_SCOPE_AGENT); }
__device__ __forceinline__ unsigned xb_add(unsigned* p, unsigned v) { return __hip_atomic_fetch_add(p, v, __ATOMIC_RELAXED, __HIP_MEMORY_SCOPE_AGENT); }
__device__ __forceinline__ unsigned xb_xcc_id() { return (unsigned)__builtin_amdgcn_s_getreg((3 << 11) | 20) & 0xFu; }
#define XB_SPIN(cond, bar) do { unsigned _sp = 0; while (cond) { __builtin_amdgcn_s_sleep(1); \
    if ((++_sp & 255u) == 0u) { if (xb_ld(&(bar)[XB_TMO])) break; if (_sp > XB_SPIN_CAP) { atomicAdd(&(bar)[XB_TMO], 1u); break; } } } } while (0)

struct XcdBarrier {
    unsigned* bar; unsigned x;
    volatile LAS unsigned* st;
};

__device__ __forceinline__ XcdBarrier xcd_barrier_post(unsigned* bar, volatile LAS unsigned* st) {
    XcdBarrier b; b.bar = bar; b.x = xb_xcc_id(); b.st = st;
    if (threadIdx.x == 0) (void)xb_add(&bar[XB_XCNT(b.x)], 1u);
    return b;
}
__device__ __forceinline__ void xcd_barrier_complete(unsigned* bar, unsigned x, unsigned& nloc, unsigned& nx) {
    const unsigned G = gridDim.x * gridDim.y * gridDim.z;
    unsigned sum, cnt, mine, sp = 0u;
    for (;;) {
        sum = 0u; cnt = 0u; mine = 0u;
#pragma unroll
        for (unsigned j = 0; j < 16; ++j) { const unsigned c = xb_ld(&bar[XB_XCNT(j)]); sum += c; cnt += (c > 0u) ? 1u : 0u; mine = (j == x) ? c : mine; }
        if (sum == G) break;
        __builtin_amdgcn_s_sleep(1);
        if ((++sp & 255u) == 0u) { if (xb_ld(&bar[XB_TMO])) break; if (sp > XB_SPIN_CAP) { atomicAdd(&bar[XB_TMO], 1u); break; } }
    }
    nloc = mine > 0u ? mine : 1u; nx = cnt > 0u ? cnt : 1u;
}

__device__ __forceinline__ void xcd_barrier(const XcdBarrier& b) {
    asm volatile("s_waitcnt vmcnt(0)" ::: "memory");
    __syncthreads();
    if (threadIdx.x == 0) {
        unsigned* bar = b.bar;
        __builtin_amdgcn_s_waitcnt(0);
        unsigned nloc = b.st[0], nx = b.st[1];
        if (nloc == 0u) { xcd_barrier_complete(bar, b.x, nloc, nx); b.st[0] = nloc; b.st[1] = nx; }
        const unsigned old = xb_add(&bar[XB_XSUB(b.x)], 1u);
        const unsigned gen = old / nloc;
        if (old + 1u == (gen + 1u) * nloc) {
            __builtin_amdgcn_fence(__ATOMIC_RELEASE, "agent");
            asm volatile("s_waitcnt vmcnt(0)" ::: "memory");
            const unsigned og = xb_add(&bar[XB_TOP], 1u);
            const unsigned tg = og / nx;
            if (og + 1u == (tg + 1u) * nx) xb_add(&bar[XB_TOPGEN], 1u);
            else XB_SPIN(xb_ld(&bar[XB_TOPGEN]) == tg, bar);
            __builtin_amdgcn_fence(__ATOMIC_ACQUIRE, "agent");
            xb_add(&bar[XB_XGEN(b.x)], 1u);
            asm volatile("s_waitcnt vmcnt(0)" ::: "memory");
        } else {
            XB_SPIN(xb_ld(&bar[XB_XGEN(b.x)]) == gen, bar);
            __builtin_amdgcn_fence(__ATOMIC_ACQUIRE, "agent");
            asm volatile("s_waitcnt vmcnt(0)" ::: "memory");
        }
    }
    __syncthreads();
}

}
__global__ void __launch_bounds__(512, 2) fwd_mega(P p_unused) {
  const unsigned long long kp = (unsigned long long)__builtin_amdgcn_kernarg_segment_ptr();
  extern __shared__ __attribute__((aligned(16))) unsigned char lds_raw[];
  LAS unsigned char* lds = (LAS unsigned char*)lds_raw;
  cg::grid_group grid = cg::this_grid();
#ifndef REP_SYNC
#define REP_SYNC 1
#endif
#ifndef REP_P0
#define REP_P0 1
#endif
  unsigned bar_gen = 0; (void)bar_gen;
  volatile LAS unsigned* xb_st = (volatile LAS unsigned*)(lds + LDS_BYTES - 64);
  if (threadIdx.x < 4) xb_st[threadIdx.x] = 0u;
  __syncthreads();
  xb::XcdBarrier xbar = xb::xcd_barrier_post((unsigned*)(load_params(kp).ws + WS_XBAR), xb_st);
#ifndef PROF_SEAM
#define PROF_SEAM -1
#endif
  int seam_id = 0; (void)seam_id;
#ifndef PROF_PHASE
#define PROF_PHASE -1
#endif
  unsigned long long pp_prev = 0, pp_acc = 0; (void)pp_prev; (void)pp_acc;
#define QNEXT(qi, uvar) int uvar; { unsigned q_ = 0u; LAS unsigned* slot_ = (LAS unsigned*)(lds + LDS_BYTES - 16); \
      \
    if (threadIdx.x == 0) q_ = __hip_atomic_fetch_add((unsigned*)(load_params(kp).ws + WS_BAR) + 16 + (qi), 1u, __ATOMIC_RELAXED, __HIP_MEMORY_SCOPE_AGENT); \
    __syncthreads(); if (threadIdx.x == 0) *slot_ = q_; \
    __syncthreads(); uvar = __builtin_amdgcn_readfirstlane((int)*slot_); }
#define GSYNC() do { for (int rs_ = 0; rs_ < REP_SYNC; ++rs_) { ++bar_gen; xb::xcd_barrier(xbar); } } while (0)
  const int G = gridDim.x, bid = blockIdx.x;
#define IDS() const int tid = (int)threadIdx.x + opaque_zero(), lane = tid & 63, wv = tid >> 6, wave = __builtin_amdgcn_readfirstlane(wv); \
  const int gw = bid * 8 + wave, NGW = G * 8; (void)lane; (void)wv; (void)wave; (void)gw; (void)NGW;
#define LOADP() const P p = load_params(kp); bf16_t* H = (bf16_t*)(p.ws + WS_H); bf16_t* MIX = (bf16_t*)(p.ws + WS_MIX); bf16_t* PROJ = (bf16_t*)(p.ws + WS_PROJ); \
  bf16_t* YO = (bf16_t*)(p.ws + WS_PROJ); bf16_t* S5Y = (bf16_t*)(p.ws + WS_S5Y); const float* rc = (const float*)(p.ws + WS_ROPE); const float* rs = rc + SEQ * 32; \
  (void)H; (void)MIX; (void)PROJ; (void)YO; (void)S5Y; (void)rc; (void)rs;

#ifndef SKIP_P0
  for (int rep = 0; rep < REP_P0; ++rep) { IDS(); LOADP(); phase0(p, lds, tid, lane, wave); }
#endif
  if (load_params(kp).ws == nullptr) grid.sync();
  GSYNC();

#pragma unroll 1
  for (int layer = 0; layer < DEPTH; ++layer) {
#ifndef REP_P1
#define REP_P1 1
#endif
#ifndef REP_P5
#define REP_P5 1
#endif
#ifndef SKIP_P1
    for (int rep = 0; rep < REP_P1; ++rep) { LOADP();
      pg8::Gemm g{H, (const bf16_t*)(p.ws + WS_WIN) + (size_t)layer * NPAD * DM, MTOK, NPAD, DM};
      pg8::StaticOrder S; S.init(MTOK, NPAD, G, bid);
      EpiProj E{PROJ, rc, rs};
      pg8::gemm_phase<EpiProj, pg8::StaticOrder, true, true>(lds, g, S, E);
    }
#endif
    seam_id = 0;
    GSYNC();
#ifndef REP_P2
#define REP_P2 1
#endif
#ifndef REP_P3
#define REP_P3 1
#endif
#ifndef REP_P4
#define REP_P4 1
#endif
#ifndef SKIP_P2
    for (int rep = 0; rep < REP_P2; ++rep) {
      constexpr int U_KM = 64, U_S5 = 256, U_CONV = 512, U_MV = 128, U_SV = 64, U_DT = 64;
      constexpr int NU = U_KM + U_S5 + U_CONV + U_MV + U_SV + U_DT;
      for (;;) {
        QNEXT(rep * 16 + layer * 4 + 0, u); if (u >= NU) break;
        IDS(); LOADP();
        int r = u;
        if (r < U_KM) { kmean_unit(p, r, tid, lane, wv, lds); continue; } r -= U_KM;
        if (r < U_S5) { s5_m1_task(p, layer, r * 8 + wv, lane); continue; } r -= U_S5;
        if (r < U_CONV) { conv_unit(p, layer, r >> 1, r & 1, lane, wv); continue; } r -= U_CONV;
        if (r < U_MV) { vtrans_tile<16>(p, r * 128 + wv * 16, C_MV, lane * 8, 8, (bf16_t*)(p.ws + WS_MVT)); continue; } r -= U_MV;
        if (r < U_SV) { vtrans_tile<8>(p, r * 256 + (wv * 4 + (lane >> 4)) * 8, C_SV, (lane & 15) * 8, 2, (bf16_t*)(p.ws + WS_SVT)); continue; } r -= U_SV;
        dtscan_unit(p, layer, r, lane, wv);
      }
    }
#endif
    seam_id = 1;
    GSYNC();
#ifndef SKIP_P3
    for (int rep = 0; rep < REP_P3; ++rep) {
      constexpr int U_ST = 32, U_MOBA = 512, U_S5 = 256, U_SWA = 128;
      constexpr int NU = U_ST + U_MOBA + U_S5 + U_SWA;
      for (;;) {
        QNEXT(rep * 16 + layer * 4 + 1, u); if (u >= NU) break;
        IDS(); LOADP();
        int r = u;
        if (r < U_ST) { ssd_state_unit(p, r, lane, wv, tid, lds); continue; }
        r -= U_ST;
        if (r < 320 || r >= 320 + U_S5 + U_SWA) {
          const int rr = r < 320 ? r : r - (U_S5 + U_SWA);
          const int qb = 15 - (rr >> 5), h = rr & 7, b = (rr >> 3) & 3;
          moba_subunit(p, b, h, qb, wave, wv, lane, tid, lds);
          continue; }
        r -= 320;
        if (r < U_S5) { s5_m2_task(p, layer, r * 8 + wave, r * 8 + wv, lane, (LAS bf16_t*)(lds + wv * (32 * S5_XP * 2 + 4096))); continue; }
        r -= U_S5;
        { const int Q = 15 - (r & 15), kvh = (r >> 4) & 1, b = r >> 5; swa_unit(p, layer, b, kvh, Q, wave, wv, lane, tid, lds); }
      }
    }
#endif
    seam_id = 2;
    GSYNC();
#ifndef SKIP_P4
    for (int rep = 0; rep < REP_P4; ++rep) {
      for (;;) {
        QNEXT(rep * 16 + layer * 4 + 2, u); if (u >= 256 + 128) break;
        IDS(); LOADP();
        if (u < 256) {
          const int half = 1 - (u >> 7), rest = u & 127;
          ssd_out_unit(p, layer, (rest << 1) | half, lds, tid, lane, wave, wv);
        } else {
          const int t = u - 256;
          pg8::Gemm g{S5Y, (const bf16_t*)(p.ws + WS_GLU) + (size_t)layer * 512 * 512, MTOK, 512, 512, S5YP};
          OneUnit S{t >> 1, t & 1};
          EpiGlu E{MIX, S5Y, PROJ, p.glu_b + layer * 512};
          pg8::gemm_phase<EpiGlu, OneUnit, false, true>(lds, g, S, E);
        }
      }
    }
#endif
    seam_id = 3;
    GSYNC();
#ifndef SKIP_P5
    for (int rep = 0; rep < REP_P5; ++rep) { LOADP();
      pg8::Gemm g{MIX, (const bf16_t*)(p.ws + WS_WOUT) + (size_t)layer * DM * MIXW, MTOK, DM, MIXW};
      pg8::StaticOrder S; S.init(MTOK, DM, G, bid);
      EpiYo E{YO, DM};
      pg8::gemm_phase<EpiYo, pg8::StaticOrder, true, true>(lds, g, S, E);
    }
#endif
    seam_id = 4;
    GSYNC();
#ifndef REP_P6
#define REP_P6 1
#endif
    for (int rep = 0; rep < (layer == 0 ? REP_P6 : 1); ++rep) { IDS(); LOADP();
      const float* ng = layer + 1 < DEPTH ? p.pre_norm + (layer + 1) * DM : nullptr;
      bf16_t* XR = (bf16_t*)(p.ws + WS_XR);
      const float* pgp = p.post_norm + layer * DM;
      if (layer == 0) { for (int m = gw; m < MTOK; m += 2 * NGW) postnorm_rows<2, false, true>(YO, p.x, XR, pgp, ng, H, m, NGW, lane); }
      else if (layer + 1 < DEPTH) { for (int m = gw; m < MTOK; m += 2 * NGW) postnorm_rows<2, true, true>(YO, XR, XR, pgp, ng, H, m, NGW, lane); }
      else { for (int m = gw; m < MTOK; m += 2 * NGW) postnorm_rows<2, true, false>(YO, XR, p.out, pgp, ng, H, m, NGW, lane); }
    }
    seam_id = 5;
    if (layer + 1 < DEPTH) GSYNC();
  }
}

extern "C" void kernel_launch(void* const* d_in, const int* in_sizes, int n_in, void* d_out, int out_size,
                              void* d_ws, size_t ws_size, hipStream_t stream) {
  static int grid = 0;
  if (grid == 0) {
    if (n_in != 22 || out_size != MTOK * DM || ws_size < WS_END) { fprintf(stderr, "kernel_launch: unexpected shapes (n_in %d out %d ws %zu need %zu)\n", n_in, out_size, ws_size, (size_t)WS_END); grid = -1; return; }
    int dev = 0, cus = 0, per_cu = 0;
    (void)hipGetDevice(&dev);
    (void)hipDeviceGetAttribute(&cus, hipDeviceAttributeMultiprocessorCount, dev);
    (void)hipFuncSetAttribute((const void*)fwd_mega, hipFuncAttributeMaxDynamicSharedMemorySize, LDS_BYTES);
    (void)hipOccupancyMaxActiveBlocksPerMultiprocessor(&per_cu, (const void*)fwd_mega, 512, LDS_BYTES);
    if (per_cu < 1) per_cu = 1;
    if (per_cu > 1) per_cu = 1;
    grid = cus * per_cu;
    fprintf(stderr, "kernel_launch: grid %d, ws %zu (need %zu)\n", grid, ws_size, (size_t)WS_END);
  }
  if (grid < 0) return;
  P p{};
  const float** pp = (const float**)&p;
  for (int i = 0; i < 22; ++i) pp[i] = (const float*)d_in[i];
  p.out = (float*)d_out; p.ws = (unsigned char*)d_ws;
  (void)hipMemsetAsync((unsigned char*)d_ws + WS_BAR, 0, 1024 + 16384, stream);
  void* args[] = {&p};
  hipError_t e = hipLaunchCooperativeKernel((const void*)fwd_mega, dim3(grid), dim3(512), args, LDS_BYTES, stream);
  if (e != hipSuccess) fprintf(stderr, "kernel_launch: cooperative launch failed: %s (grid %d)\n", hipGetErrorString(e), grid);
}
```
